# Optimizing an MI355X kernel written in HIP

```python
import math
import jax, jax.numpy as jnp
from jax import lax
import numpy as np

D_MODEL = 1024
BATCH = 2
SEQ = 8192
DEPTH = 1

D_PLE = 256
M_HEADS = 4
M_QK = 128
M_V = 256
M_WIDTH = M_HEADS * M_V
M_CHUNK = 64
CONV_W = 4
A_HEADS = 8
A_DH = 64
A_WIDTH = A_HEADS * A_DH
IDX_HEADS = 8
IDX_DH = 64
TOPK_MAX = 256
Q_BLOCK = 128
REL_BUCKETS = 32
REL_MAX_DIST = 128
D_MIX = M_WIDTH + A_WIDTH
EPS = 1e-6

PROJ_SIZES = [
    M_HEADS * M_QK,
    M_HEADS * M_QK,
    M_WIDTH,
    M_WIDTH,
    M_WIDTH,
    2 * M_HEADS,
    A_WIDTH,
    A_WIDTH,
    A_WIDTH,
    A_WIDTH,
    IDX_HEADS * IDX_DH,
    IDX_DH,
    IDX_HEADS,
]
PROJ_TOTAL = int(sum(PROJ_SIZES))
SPLIT_POINTS = [int(v) for v in np.cumsum(PROJ_SIZES)[:-1]]

kernel_name = "hybrid_mlstm_dsa_parallel_heads"


def rmsnorm(x, g):
    xf = x.astype(jnp.float32)
    y = xf * lax.rsqrt(jnp.mean(xf * xf, axis=-1, keepdims=True) + EPS)
    return (y * g.astype(jnp.float32)).astype(x.dtype)


def causal_dwconv(x, w):
    S = x.shape[1]
    xp = jnp.pad(x, ((0, 0), (CONV_W - 1, 0), (0, 0)))
    y = xp[:, 0:S] * w[0]
    for j in range(1, CONV_W):
        y = y + xp[:, j:j + S] * w[j]
    return y


def mlstm_chunkwise(q, k, v, log_i, log_f):
    f32 = jnp.float32
    B, S, H, Dk = q.shape
    Dv = v.shape[-1]
    L = M_CHUNK
    NC = S // L

    def to_chunks(a):
        return a.reshape((B, NC, L) + a.shape[2:]).swapaxes(0, 1)

    qc = to_chunks(q.astype(f32))
    kc = to_chunks(k.astype(f32) * (Dk ** -0.5))
    vc = to_chunks(v.astype(f32))
    ic = to_chunks(log_i.astype(f32))
    fc = to_chunks(log_f.astype(f32))
    causal = jnp.tril(jnp.ones((L, L), dtype=bool))

    def step(carry, inp):
        C, n, m = carry
        q_, k_, v_, li, lf = inp
        b = jnp.cumsum(lf, axis=1).transpose(0, 2, 1)
        li_h = li.transpose(0, 2, 1)
        D = b[:, :, :, None] - b[:, :, None, :] + li_h[:, :, None, :]
        D = jnp.where(causal, D, -jnp.inf)
        inter = b + m[:, :, None]
        m_t = jnp.maximum(inter, D.max(-1))
        s = jnp.einsum('blhd,bshd->bhls', q_, k_) * jnp.exp(D - m_t[..., None])
        w_inter = jnp.exp(inter - m_t)
        num = (jnp.einsum('bhls,bshv->blhv', s, v_)
               + w_inter.transpose(0, 2, 1)[..., None] * jnp.einsum('blhd,bhdv->blhv', q_, C))
        den = s.sum(-1) + w_inter * jnp.einsum('blhd,bhd->bhl', q_, n)
        den = jnp.maximum(jnp.abs(den), jnp.exp(-m_t))
        h = num / den.transpose(0, 2, 1)[..., None]
        b_L = b[:, :, -1]
        g = b_L[:, :, None] - b + li_h
        m_new = jnp.maximum(b_L + m, g.max(-1))
        wk = jnp.exp(g - m_new[..., None])
        decay = jnp.exp(b_L + m - m_new)
        C_new = decay[..., None, None] * C + jnp.einsum('bhs,bshd,bshv->bhdv', wk, k_, v_)
        n_new = decay[..., None] * n + jnp.einsum('bhs,bshd->bhd', wk, k_)
        return (C_new, n_new, m_new), h

    init = (jnp.zeros((B, H, Dk, Dv), f32), jnp.zeros((B, H, Dk), f32), jnp.zeros((B, H), f32))
    _, hs = lax.scan(step, init, (qc, kc, vc, ic, fc))
    return hs.swapaxes(0, 1).reshape(B, S, H, Dv)


def t5_bucket(dist):
    max_exact = REL_BUCKETS // 2
    large = max_exact + (jnp.log(jnp.maximum(dist, 1).astype(jnp.float32) / max_exact)
                         / math.log(REL_MAX_DIST / max_exact) * (REL_BUCKETS - max_exact)).astype(jnp.int32)
    large = jnp.minimum(large, REL_BUCKETS - 1)
    return jnp.where(dist < max_exact, dist, large)


def dsa_attention(q, k, v, iq, ik, iw, rel_bias):
    B, S, H, dh = q.shape
    topk = min(TOPK_MAX, S // 4)
    NB = S // Q_BLOCK
    key_pos = jnp.arange(S)
    iq = iq * (IDX_DH ** -0.5)
    iw = iw * (IDX_HEADS ** -0.5)

    def blockify(a):
        return a.reshape((B, NB, Q_BLOCK) + a.shape[2:]).swapaxes(0, 1)

    def one_block(args):
        qb, iqb, iwb, bi = args
        t = bi * Q_BLOCK + jnp.arange(Q_BLOCK)
        sc = jax.nn.relu(jnp.einsum('bthd,bsd->bths', iqb, ik))
        score = jnp.einsum('bths,bth->bts', sc, iwb).astype(jnp.float32)
        causal = key_pos[None, :] <= t[:, None]
        score = jnp.where(causal[None], score, -jnp.inf)
        _, idx = lax.top_k(score, topk)
        k_sel = jax.vmap(lambda kb, ib: kb[ib])(k, idx)
        v_sel = jax.vmap(lambda vb, ib: vb[ib])(v, idx)
        valid = idx <= t[None, :, None]
        bucket = t5_bucket(jnp.maximum(t[None, :, None] - idx, 0))
        bias = rel_bias[bucket].astype(jnp.float32).transpose(0, 1, 3, 2)
        logits = jnp.einsum('bthd,btkhd->bthk', qb, k_sel).astype(jnp.float32) * (dh ** -0.5) + bias
        logits = jnp.where(valid[:, :, None, :], logits, -jnp.inf)
        probs = jax.nn.softmax(logits, axis=-1).astype(v.dtype)
        return jnp.einsum('bthk,btkhd->bthd', probs, v_sel)

    out = lax.map(one_block, (blockify(q), blockify(iq), blockify(iw), jnp.arange(NB)))
    return out.swapaxes(0, 1).reshape(B, S, H, dh)


def setup_inputs(seed: int = 0) -> dict:
    key = jax.random.key(seed)
    ks = jax.random.split(key, 16)
    f32 = jnp.float32
    x = jax.random.normal(ks[0], (BATCH, SEQ, D_MODEL), f32)
    p = jax.random.normal(ks[1], (DEPTH, BATCH, SEQ, D_PLE), f32)
    w_in = jax.random.normal(ks[2], (DEPTH, D_MODEL, PROJ_TOTAL), f32) * D_MODEL ** -0.5
    i_bias = 0.1 * jax.random.normal(ks[3], (DEPTH, M_HEADS), f32)
    f_bias = jnp.linspace(3.0, 6.0, M_HEADS, dtype=f32)[None] + 0.1 * jax.random.normal(ks[4], (DEPTH, M_HEADS), f32)
    b_gate = jnp.concatenate([i_bias, f_bias], axis=-1)
    conv_w = jax.random.normal(ks[5], (DEPTH, CONV_W, 2 * M_HEADS * M_QK), f32) * CONV_W ** -0.5
    w_out = jax.random.normal(ks[6], (DEPTH, D_MIX, D_MODEL), f32) * D_MIX ** -0.5
    norm_in = 1.0 + 0.1 * jax.random.normal(ks[7], (DEPTH, D_MODEL), f32)
    m_norm = 1.0 + 0.1 * jax.random.normal(ks[8], (DEPTH, M_WIDTH), f32)
    rel_bias = 0.5 * jax.random.normal(ks[9], (REL_BUCKETS, A_HEADS), f32)
    w_ple = jax.random.normal(ks[10], (DEPTH, D_PLE, D_MODEL), f32) * D_PLE ** -0.5
    w_ple_gate = jax.random.normal(ks[11], (DEPTH, D_MODEL, D_MODEL), f32) * D_MODEL ** -0.5
    norm_final = 1.0 + 0.1 * jax.random.normal(ks[12], (D_MODEL,), f32)
    return {"x": x, "p": p, "w_in": w_in, "b_gate": b_gate, "conv_w": conv_w, "w_out": w_out,
            "norm_in": norm_in, "m_norm": m_norm, "rel_bias": rel_bias, "w_ple": w_ple,
            "w_ple_gate": w_ple_gate, "norm_final": norm_final}


def reference(x, p, w_in, b_gate, conv_w, w_out, norm_in, m_norm, rel_bias, w_ple, w_ple_gate, norm_final):
    B, S, _ = x.shape
    h = x
    for i in range(DEPTH):
        u = rmsnorm(h, norm_in[i])
        proj = u @ w_in[i]
        (m_q, m_k, m_v, m_o, m_z, m_if, a_q, a_k, a_v, a_z,
         ix_q, ix_k, ix_w) = jnp.split(proj, SPLIT_POINTS, axis=-1)

        qk = jax.nn.silu(causal_dwconv(jnp.concatenate([m_q, m_k], axis=-1), conv_w[i]))
        mq, mk = jnp.split(qk, 2, axis=-1)
        gates = (m_if + b_gate[i]).astype(jnp.float32)
        log_i = gates[..., :M_HEADS]
        log_f = jax.nn.log_sigmoid(gates[..., M_HEADS:])
        hm = mlstm_chunkwise(mq.reshape(B, S, M_HEADS, M_QK), mk.reshape(B, S, M_HEADS, M_QK),
                             m_v.reshape(B, S, M_HEADS, M_V), log_i, log_f)
        hm = hm * lax.rsqrt(jnp.mean(hm * hm, axis=-1, keepdims=True) + EPS)
        hm = hm.reshape(B, S, M_WIDTH) * m_norm[i].astype(jnp.float32)
        hm = jax.nn.sigmoid(m_o) * hm.astype(x.dtype) * jax.nn.silu(m_z)

        ha = dsa_attention(a_q.reshape(B, S, A_HEADS, A_DH), a_k.reshape(B, S, A_HEADS, A_DH),
                           a_v.reshape(B, S, A_HEADS, A_DH), ix_q.reshape(B, S, IDX_HEADS, IDX_DH),
                           ix_k, ix_w, rel_bias)
        ha = ha.reshape(B, S, A_WIDTH) * jax.nn.silu(a_z)

        h = h + jnp.concatenate([hm, ha], axis=-1) @ w_out[i]

        h = h + (p[i] @ w_ple[i]) * jax.nn.sigmoid(h @ w_ple_gate[i])
    return rmsnorm(h, norm_final)
```

```cpp
#include <hip/hip_runtime.h>
#include <cstdio>
#include <cstdint>
#ifndef DEBUG_CHECKS
#define DEBUG_CHECKS 0
#endif

constexpr int BATCH = 2, SEQ = 8192, DM = 1024, M = BATCH * SEQ;
constexpr int NPROJ = 6736, NPAD = 6912;
constexpr int DMIX = 1536, DPLE = 256;
constexpr float EPS = 1e-6f;
constexpr float LOG2E = 1.4426950408889634f;
constexpr float C2 = 0.125f * LOG2E;

constexpr size_t MiB = 1u << 20;
constexpr size_t WS_CTL = 0, CTL_ZERO_BYTES = 1 * MiB;
constexpr size_t WS_WIN = 1 * MiB;
constexpr size_t WS_WOUT = 15 * MiB;
constexpr size_t WS_WGATE = 18 * MiB;
constexpr size_t WS_WPLE = 20 * MiB;
constexpr size_t WS_BT = 20 * MiB + 512 * 1024;
constexpr size_t WS_IK = 21 * MiB;
constexpr size_t WS_IW = 23 * MiB;
constexpr size_t WS_GATES = 23 * MiB + 512 * 1024;
constexpr size_t WS_P16 = 24 * MiB;
constexpr size_t WS_XN = 32 * MiB;
constexpr size_t WS_IQ = 64 * MiB;
constexpr size_t WS_MIX = 32 * MiB;
constexpr size_t WS_AQ = 80 * MiB, WS_AK = 96 * MiB, WS_AV = 112 * MiB, WS_AZ = 128 * MiB;
constexpr size_t WS_H1H = 80 * MiB;
constexpr size_t WS_PB = 112 * MiB;
constexpr size_t WS_MG = 144 * MiB;
constexpr size_t WS_MASK = 176 * MiB;
constexpr size_t WS_H1 = 192 * MiB;
constexpr size_t WS_END = 256 * MiB;
constexpr size_t WS_DBG = 14 * MiB + 512 * 1024;
constexpr size_t WS_FLAGS = 512 * 1024;
constexpr size_t DO_MQ = 0, DO_MK = 16 * MiB, DO_MV = 32 * MiB;

typedef _Float16 h16;
typedef _Float16 h16x2 __attribute__((ext_vector_type(2)));
typedef _Float16 h16x8 __attribute__((ext_vector_type(8)));
typedef short s16x8 __attribute__((ext_vector_type(8)));
typedef float f32x4 __attribute__((ext_vector_type(4)));
typedef float f32x2 __attribute__((ext_vector_type(2)));
typedef unsigned u32x4 __attribute__((ext_vector_type(4)));
typedef unsigned u32x2 __attribute__((ext_vector_type(2)));
#define LAS __attribute__((address_space(3)))
#define GAS __attribute__((address_space(1)))

__device__ __forceinline__ unsigned pkh(float lo, float hi) { h16x2 v = {(h16)lo, (h16)hi}; return __builtin_bit_cast(unsigned, v); }
__device__ __forceinline__ float sigmoidf_(float x) { return 1.0f / (1.0f + __expf(-x)); }
__device__ __forceinline__ float siluf_(float x) { return x / (1.0f + __expf(-x)); }
__device__ __forceinline__ float h2f(unsigned short b) { return (float)__builtin_bit_cast(h16, b); }

struct Args { const float* in[12]; float* out; unsigned char* ws; int pad0, pad1; };

namespace pg8 {
constexpr int BM = 256, BK = 64, HALF = 128, HTB = HALF * BK * 2, STAGE_BYTES = 8 * HTB, NXCD = 8, WGM = 8;
__host__ __device__ __forceinline__ int lds_byte(int r, int c) { const int st = (r >> 4) * 2 + (c >> 5), rr = r & 15, cc = c & 31, ob = rr * 64 + cc * 2; return st * 1024 + (ob ^ (((ob >> 9) & 1) << 5)); }
__host__ __device__ __forceinline__ void stage_rc(int b, int& R, int& C) { const int st = b / 1024, sb = b % 1024, swz = sb ^ (((sb >> 9) & 1) << 5); R = (st >> 1) * 16 + swz / 64; C = (st & 1) * 32 + (swz % 64) / 2; }
__host__ __device__ __forceinline__ int perm32(int rho) { const int n = rho >> 4, i = rho & 15; return 8 * (i >> 2) + 4 * n + (i & 3); }

struct Unit { int pm, pn; };
struct Gemm { const h16* A; const h16* Bt; int M, N, K; };

struct StaticOrder {
    int nM, nN, nwg, G, c;
    __host__ __device__ void init(int M_, int N_, int G_, int c_) { nM = M_ / BM; nN = N_ / BM; nwg = nM * nN; G = G_; c = c_; }
    __host__ __device__ bool next(int i, Unit& u) const {
        const long L = (long)i * G + c; if (L >= nwg) return false;
        int wgid = (int)L; { const int q = nwg / NXCD, r = nwg % NXCD, xcd = wgid % NXCD, off = wgid / NXCD; wgid = (xcd < r ? xcd * (q + 1) : r * (q + 1) + (xcd - r) * q) + off; }
        const int nig = WGM * nN, gid = wgid / nig, fm = gid * WGM, gsz = (nM - fm) < WGM ? (nM - fm) : WGM;
        u.pm = fm + ((wgid % nig) % gsz); u.pn = (wgid % nig) / gsz; return true;
    }
};

template <class Epi, class Sched, bool ALIGN_EPI = false, bool SP2 = false>
__device__ __forceinline__ void gemm_phase(LAS unsigned char* lds, const Gemm g, const Sched& S, const Epi& E) {
    const int tid = threadIdx.x, wid = __builtin_amdgcn_readfirstlane(tid >> 6), lane = tid & 63, wr = wid >> 2, wc = wid & 3, fr = lane & 15, fq = lane >> 4;
    const int K = g.K, nt = K / BK;
    unsigned voffA[2], voffB[2];
#pragma unroll
    for (int i = 0; i < 2; ++i) { int R, C; stage_rc(tid * 16 + i * 8192, R, C); const int Rb = Epi::PERM ? ((R & ~31) + perm32(R & 31)) : R;
        voffA[i] = (unsigned)(R * K + C) * 2u; voffB[i] = (unsigned)(Rb * K + C) * 2u; }
    const size_t kstep = (size_t)(BK * 2);
    const size_t hstep = (size_t)HALF * K * 2;
    const size_t tstep = 2 * hstep;
    const unsigned ldsw = (unsigned)wid * 1024u;
    const int aoff = lds_byte(wr * 64 + fr, fq * 8), boff = lds_byte(wc * 32 + fr, fq * 8);
#define PG8_SA(b, h) (((b) * 2 + (h)) * HTB)
#define PG8_SB(b, h) ((4 + (b) * 2 + (h)) * HTB)
#define PG8_STAGE(bufoff, gbase, voff) do { _Pragma("unroll") for (int _i = 0; _i < 2; ++_i) \
        __builtin_amdgcn_global_load_lds((const unsigned*)((const char*)(gbase) + (voff)[_i]), (LAS unsigned*)(lds + (bufoff) + ldsw + _i * 8192), 16, 0, 0); } while (0)
#define PG8_LDA(dst, b, h) do { _Pragma("unroll") for (int m = 0; m < 4; ++m) _Pragma("unroll") for (int k = 0; k < 2; ++k) dst[m][k] = *(const LAS h16x8*)(lds + PG8_SA(b, h) + aoff + m * 2048 + k * 1024); } while (0)
#define PG8_LDB(dst, b, h) do { _Pragma("unroll") for (int n = 0; n < 2; ++n) _Pragma("unroll") for (int k = 0; k < 2; ++k) dst[n][k] = *(const LAS h16x8*)(lds + PG8_SB(b, h) + boff + n * 2048 + k * 1024); } while (0)
#define PG8_MMA(ai, bj, At, Bt) do { __builtin_amdgcn_s_setprio(1); _Pragma("unroll") for (int m = 0; m < 4; ++m) _Pragma("unroll") for (int n = 0; n < 2; ++n) _Pragma("unroll") for (int k = 0; k < 2; ++k) \
        acc[ai][bj][m][n] = __builtin_amdgcn_mfma_f32_16x16x32_f16(Bt[n][k], At[m][k], acc[ai][bj][m][n], 0, 0, 0); __builtin_amdgcn_s_setprio(0); } while (0)
#define PG8_WAIT_V(n) asm volatile("s_waitcnt vmcnt(" #n ")" ::: "memory")
#define PG8_WAIT_L(n) asm volatile("s_waitcnt lgkmcnt(" #n ")" ::: "memory")
#define PG8_BAR __builtin_amdgcn_s_barrier()
#define PG8_SCHED __builtin_amdgcn_sched_barrier(0)
    Unit cur, nxt; int ui = 0;
    if (!S.next(0, cur)) return;
    f32x4 acc[2][2][4][2];
#pragma unroll
    for (int a = 0; a < 2; ++a)
#pragma unroll
        for (int b = 0; b < 2; ++b)
#pragma unroll
            for (int m = 0; m < 4; ++m)
#pragma unroll
                for (int n = 0; n < 2; ++n) acc[a][b][m][n] = (f32x4){0.f, 0.f, 0.f, 0.f};
    h16x8 At[4][2], B0[2][2], B1[2][2];
    const char* cA = (const char*)g.A + (size_t)cur.pm * tstep; const char* cB = (const char*)g.Bt + (size_t)cur.pn * tstep;
    if constexpr (SP2) {
        PG8_STAGE(PG8_SB(0, 0), cB, voffB); PG8_STAGE(PG8_SB(0, 1), cB + hstep, voffB); PG8_STAGE(PG8_SA(0, 0), cA, voffA); PG8_STAGE(PG8_SA(0, 1), cA + hstep, voffA);
        if (wr == 1) PG8_BAR;
        PG8_WAIT_V(2); PG8_BAR;
        PG8_STAGE(PG8_SB(1, 0), cB + kstep, voffB); PG8_STAGE(PG8_SA(1, 0), cA + kstep, voffA); PG8_STAGE(PG8_SB(1, 1), cB + hstep + kstep, voffB);
        PG8_WAIT_V(6); PG8_BAR;
    } else {
        PG8_STAGE(PG8_SB(0, 0), cB, voffB); PG8_STAGE(PG8_SA(0, 0), cA, voffA); PG8_STAGE(PG8_SB(0, 1), cB + hstep, voffB); PG8_STAGE(PG8_SA(0, 1), cA + hstep, voffA);
        if (wr == 1) PG8_BAR;
        PG8_WAIT_V(4); PG8_BAR;
        PG8_STAGE(PG8_SB(1, 0), cB + kstep, voffB); PG8_STAGE(PG8_SA(1, 0), cA + kstep, voffA); PG8_STAGE(PG8_SB(1, 1), cB + hstep + kstep, voffB);
        PG8_WAIT_V(6); PG8_BAR;
    }
    for (;;) {
        const bool has_next = S.next(ui + 1, nxt);
        const char* nA = has_next ? (const char*)g.A + (size_t)nxt.pm * tstep : cA; const char* nB = has_next ? (const char*)g.Bt + (size_t)nxt.pn * tstep : cB;
        for (int t = 0; t < nt; t += 2) {
            const bool last = (t == nt - 2);
            const char* a1 = cA + (size_t)(t + 1) * kstep;
            const char* a2 = last ? nA : cA + (size_t)(t + 2) * kstep; const char* b2 = last ? nB : cB + (size_t)(t + 2) * kstep;
            const char* a3 = a2 + kstep; const char* b3 = b2 + kstep;
            if constexpr (SP2) {
            PG8_LDB(B0, 0, 0); PG8_LDB(B1, 0, 1); PG8_SCHED; PG8_LDA(At, 0, 0); PG8_STAGE(PG8_SA(1, 1), a1 + hstep, voffA);
            PG8_WAIT_V(8); PG8_WAIT_L(0); PG8_BAR; PG8_MMA(0, 0, At, B0); PG8_MMA(0, 1, At, B1); PG8_BAR; PG8_SCHED;
            PG8_LDA(At, 0, 1); PG8_STAGE(PG8_SB(0, 0), b2, voffB); PG8_STAGE(PG8_SB(0, 1), b2 + hstep, voffB); PG8_STAGE(PG8_SA(0, 0), a2, voffA);
            PG8_WAIT_V(8); PG8_WAIT_L(0); PG8_BAR; PG8_MMA(1, 0, At, B0); PG8_MMA(1, 1, At, B1); PG8_BAR; PG8_SCHED;
            PG8_LDB(B0, 1, 0); PG8_LDB(B1, 1, 1); PG8_SCHED; PG8_LDA(At, 1, 0); PG8_STAGE(PG8_SA(0, 1), a2 + hstep, voffA);
            PG8_WAIT_V(8); PG8_WAIT_L(0); PG8_BAR; PG8_MMA(0, 0, At, B0); PG8_MMA(0, 1, At, B1); PG8_BAR; PG8_SCHED;
            PG8_LDA(At, 1, 1); PG8_STAGE(PG8_SB(1, 0), b3, voffB); PG8_STAGE(PG8_SB(1, 1), b3 + hstep, voffB); PG8_STAGE(PG8_SA(1, 0), a3, voffA);
            PG8_WAIT_V(8); PG8_WAIT_L(0); PG8_BAR; PG8_MMA(1, 0, At, B0); PG8_MMA(1, 1, At, B1); PG8_BAR; PG8_SCHED;
            } else {
            PG8_LDB(B0, 0, 0); PG8_SCHED; PG8_LDA(At, 0, 0); PG8_STAGE(PG8_SA(1, 1), a1 + hstep, voffA);
            PG8_WAIT_L(8); PG8_BAR; PG8_WAIT_L(0); PG8_MMA(0, 0, At, B0); PG8_BAR; PG8_SCHED;
            PG8_LDB(B1, 0, 1); PG8_STAGE(PG8_SB(0, 0), b2, voffB);
            PG8_BAR; PG8_WAIT_L(0); PG8_MMA(0, 1, At, B1); PG8_BAR;
            PG8_LDA(At, 0, 1); PG8_STAGE(PG8_SA(0, 0), a2, voffA);
            PG8_BAR; PG8_WAIT_L(0); PG8_MMA(1, 0, At, B0); PG8_BAR; PG8_SCHED;
            PG8_STAGE(PG8_SB(0, 1), b2 + hstep, voffB);
            PG8_WAIT_V(6); PG8_BAR; PG8_MMA(1, 1, At, B1); PG8_BAR;
            PG8_LDB(B0, 1, 0); PG8_SCHED; PG8_LDA(At, 1, 0); PG8_STAGE(PG8_SA(0, 1), a2 + hstep, voffA);
            PG8_WAIT_L(8); PG8_BAR; PG8_WAIT_L(0); PG8_MMA(0, 0, At, B0); PG8_BAR; PG8_SCHED;
            PG8_LDB(B1, 1, 1); PG8_STAGE(PG8_SB(1, 0), b3, voffB);
            PG8_BAR; PG8_WAIT_L(0); PG8_MMA(0, 1, At, B1); PG8_BAR;
            PG8_LDA(At, 1, 1); PG8_STAGE(PG8_SA(1, 0), a3, voffA);
            PG8_BAR; PG8_WAIT_L(0); PG8_MMA(1, 0, At, B0); PG8_BAR; PG8_SCHED;
            PG8_STAGE(PG8_SB(1, 1), b3 + hstep, voffB);
            PG8_WAIT_V(6); PG8_BAR; PG8_MMA(1, 1, At, B1); PG8_BAR;
            }
        }
        if constexpr (ALIGN_EPI) { if (wr == 0) PG8_BAR; }
        E(acc, cur, wr, wc, fr, fq);
        if (!has_next) break;
#pragma unroll
        for (int a = 0; a < 2; ++a)
#pragma unroll
            for (int b = 0; b < 2; ++b)
#pragma unroll
                for (int m = 0; m < 4; ++m)
#pragma unroll
                    for (int n = 0; n < 2; ++n) acc[a][b][m][n] = (f32x4){0.f, 0.f, 0.f, 0.f};
        cur = nxt; cA = nA; cB = nB; ++ui;
        if constexpr (ALIGN_EPI) { if (wr == 1) PG8_BAR; }
    }
    PG8_WAIT_V(0);
    if constexpr (!ALIGN_EPI) { if (wr == 0) PG8_BAR; }
    PG8_BAR;
#undef PG8_SA
#undef PG8_SB
#undef PG8_STAGE
#undef PG8_LDA
#undef PG8_LDB
#undef PG8_MMA
#undef PG8_WAIT_V
#undef PG8_WAIT_L
#undef PG8_BAR
#undef PG8_SCHED
}

struct EpiProj {
    static constexpr bool PERM = true;
    unsigned char* ws; unsigned char* dout; const float* b_gate;
    __device__ __forceinline__ void operator()(const f32x4 (&acc)[2][2][4][2], const Unit& u, int wr, int wc, int fr, int fq) const {
        const int pn = u.pn; const int row0 = u.pm * BM + wr * 64 + fr; const int cw = wc * 32 + 8 * fq;
        if (pn >= 8 && pn < 16) {
            h16* base = (h16*)(ws + WS_MG) + (pn - 8) * 128 + cw;
#pragma unroll
            for (int ai = 0; ai < 2; ++ai)
#pragma unroll
                for (int m = 0; m < 4; ++m) { const f32x4 o0 = acc[ai][0][m][0], o1 = acc[ai][0][m][1], z0 = acc[ai][1][m][0], z1 = acc[ai][1][m][1];
                    float r[8];
#pragma unroll
                    for (int j = 0; j < 4; ++j) { r[j] = sigmoidf_(o0[j]) * siluf_(z0[j]); r[4 + j] = sigmoidf_(o1[j]) * siluf_(z1[j]); }
                    u32x4 w; w.x = pkh(r[0], r[1]); w.y = pkh(r[2], r[3]); w.z = pkh(r[4], r[5]); w.w = pkh(r[6], r[7]);
                    *(u32x4*)(base + (size_t)(row0 + ai * HALF + m * 16) * 1024) = w; }
            return;
        }
        if (pn == 26) {
            if (wc < 2) { h16* base = (h16*)(ws + WS_IK) + cw;
#pragma unroll
                for (int ai = 0; ai < 2; ++ai)
#pragma unroll
                    for (int m = 0; m < 4; ++m) { const f32x4 v0 = acc[ai][0][m][0], v1 = acc[ai][0][m][1];
                        u32x4 w; w.x = pkh(v0[0], v0[1]); w.y = pkh(v0[2], v0[3]); w.z = pkh(v1[0], v1[1]); w.w = pkh(v1[2], v1[3]);
                        *(u32x4*)(base + (size_t)(row0 + ai * HALF + m * 16) * 64) = w; }
            } else if (wc == 2 && fq == 0) { float* base = (float*)(ws + WS_IW); const float sc = 0.35355339059327373f;
#pragma unroll
                for (int ai = 0; ai < 2; ++ai)
#pragma unroll
                    for (int m = 0; m < 4; ++m) { float* p = base + (size_t)(row0 + ai * HALF + m * 16) * 8; *(f32x4*)p = acc[ai][0][m][0] * sc; *(f32x4*)(p + 4) = acc[ai][0][m][1] * sc; }
            } else if (wc == 2 && fq == 1) { float* base = (float*)(ws + WS_GATES); const f32x4 bi = *(const f32x4*)b_gate, bf = *(const f32x4*)(b_gate + 4);
#pragma unroll
                for (int ai = 0; ai < 2; ++ai)
#pragma unroll
                    for (int m = 0; m < 4; ++m) { float* p = base + (size_t)(row0 + ai * HALF + m * 16) * 8; *(f32x4*)p = acc[ai][0][m][0] + bi;
                        const f32x4 g = acc[ai][0][m][1] + bf; f32x4 lf;
#pragma unroll
                        for (int j = 0; j < 4; ++j) lf[j] = fminf(g[j], 0.f) - log1pf(expf(-fabsf(g[j])));
                        *(f32x4*)(p + 4) = lf; }
            }
            return;
        }
        h16* base; int pitch; int coff; float sc = 1.f; bool act = false;
        if (pn < 2)       { base = (h16*)(dout + DO_MQ); pitch = 512;  coff = pn * 256; }
        else if (pn < 4)  { base = (h16*)(dout + DO_MK); pitch = 512;  coff = (pn - 2) * 256; }
        else if (pn < 8)  { base = (h16*)(dout + DO_MV); pitch = 1024; coff = (pn - 4) * 256; }
        else if (pn < 18) { base = (h16*)(ws + WS_AQ);   pitch = 512;  coff = (pn - 16) * 256; sc = C2; }
        else if (pn < 20) { base = (h16*)(ws + WS_AK);   pitch = 512;  coff = (pn - 18) * 256; }
        else if (pn < 22) { base = (h16*)(ws + WS_AV);   pitch = 512;  coff = (pn - 20) * 256; }
        else if (pn < 24) { base = (h16*)(ws + WS_AZ);   pitch = 512;  coff = (pn - 22) * 256; act = true; }
        else              { base = (h16*)(ws + WS_IQ);   pitch = 512;  coff = (pn - 24) * 256; sc = 0.125f; }
#pragma unroll
        for (int ai = 0; ai < 2; ++ai)
#pragma unroll
            for (int m = 0; m < 4; ++m) { h16* rowp = base + (size_t)(row0 + ai * HALF + m * 16) * pitch + coff + cw;
#pragma unroll
                for (int bj = 0; bj < 2; ++bj) { f32x4 v0 = acc[ai][bj][m][0], v1 = acc[ai][bj][m][1];
                    if (act) {
#pragma unroll
                        for (int j = 0; j < 4; ++j) { v0[j] = siluf_(v0[j]); v1[j] = siluf_(v1[j]); } }
                    v0 = v0 * sc; v1 = v1 * sc;
                    u32x4 w; w.x = pkh(v0[0], v0[1]); w.y = pkh(v0[2], v0[3]); w.z = pkh(v1[0], v1[1]); w.w = pkh(v1[2], v1[3]);
                    *(u32x4*)(rowp + bj * HALF) = w; } }
    }
};
struct EpiF16 {
    static constexpr bool PERM = true;
    h16* O; int ldc;
    __device__ __forceinline__ void operator()(const f32x4 (&acc)[2][2][4][2], const Unit& u, int wr, int wc, int fr, int fq) const {
        const int row0 = u.pm * BM + wr * 64 + fr; const int col0 = u.pn * BM + wc * 32 + 8 * fq;
#pragma unroll
        for (int ai = 0; ai < 2; ++ai)
#pragma unroll
            for (int m = 0; m < 4; ++m) { h16* rowp = O + (size_t)(row0 + ai * HALF + m * 16) * ldc + col0;
#pragma unroll
                for (int bj = 0; bj < 2; ++bj) { const f32x4 v0 = acc[ai][bj][m][0], v1 = acc[ai][bj][m][1];
                    u32x4 w; w.x = pkh(v0[0], v0[1]); w.y = pkh(v0[2], v0[3]); w.z = pkh(v1[0], v1[1]); w.w = pkh(v1[2], v1[3]);
                    *(u32x4*)(rowp + bj * HALF) = w; } }
    }
};
struct EpiOut {
    static constexpr bool PERM = false;
    const float* x; float* h1; h16* h1h;
    __device__ __forceinline__ void operator()(const f32x4 (&acc)[2][2][4][2], const Unit& u, int wr, int wc, int fr, int fq) const {
        const int row0 = u.pm * BM + wr * 64 + fr; const int col0 = u.pn * BM + wc * 32 + 4 * fq;
#pragma unroll
        for (int ai = 0; ai < 2; ++ai)
#pragma unroll
            for (int m = 0; m < 4; ++m) { const size_t off = (size_t)(row0 + ai * HALF + m * 16) * DM + col0;
#pragma unroll
                for (int bj = 0; bj < 2; ++bj)
#pragma unroll
                    for (int n = 0; n < 2; ++n) { const size_t o = off + bj * HALF + n * 16; const f32x4 v = *(const f32x4*)(x + o) + acc[ai][bj][m][n];
                        *(f32x4*)(h1 + o) = v; u32x2 w; w.x = pkh(v[0], v[1]); w.y = pkh(v[2], v[3]); *(u32x2*)(h1h + o) = w; } }
    }
};
struct EpiGate {
    static constexpr bool PERM = false;
    float* h1; const h16* pb;
    __device__ __forceinline__ void operator()(const f32x4 (&acc)[2][2][4][2], const Unit& u, int wr, int wc, int fr, int fq) const {
        const int row0 = u.pm * BM + wr * 64 + fr; const int col0 = u.pn * BM + wc * 32 + 4 * fq;
#pragma unroll
        for (int ai = 0; ai < 2; ++ai)
#pragma unroll
            for (int m = 0; m < 4; ++m) { const size_t off = (size_t)(row0 + ai * HALF + m * 16) * DM + col0;
#pragma unroll
                for (int bj = 0; bj < 2; ++bj)
#pragma unroll
                    for (int n = 0; n < 2; ++n) { const size_t o = off + bj * HALF + n * 16; const f32x4 hv = *(const f32x4*)(h1 + o); const u32x2 pw = *(const u32x2*)(pb + o);
                        const h16x2 p01 = __builtin_bit_cast(h16x2, pw.x), p23 = __builtin_bit_cast(h16x2, pw.y); const f32x4 a = acc[ai][bj][m][n]; f32x4 r;
                        r[0] = hv[0] + (float)p01[0] * sigmoidf_(a[0]); r[1] = hv[1] + (float)p01[1] * sigmoidf_(a[1]);
                        r[2] = hv[2] + (float)p23[0] * sigmoidf_(a[2]); r[3] = hv[3] + (float)p23[1] * sigmoidf_(a[3]);
                        *(f32x4*)(h1 + o) = r; } }
    }
};
struct EpiF32 {
    static constexpr bool PERM = false;
    float* O; int ldc;
    __device__ __forceinline__ void operator()(const f32x4 (&acc)[2][2][4][2], const Unit& u, int wr, int wc, int fr, int fq) const {
        const int row0 = u.pm * BM + wr * 64 + fr; const int col0 = u.pn * BM + wc * 32 + 4 * fq;
#pragma unroll
        for (int ai = 0; ai < 2; ++ai)
#pragma unroll
            for (int m = 0; m < 4; ++m) { const size_t off = (size_t)(row0 + ai * HALF + m * 16) * ldc + col0;
#pragma unroll
                for (int bj = 0; bj < 2; ++bj)
#pragma unroll
                    for (int n = 0; n < 2; ++n) *(f32x4*)(O + off + bj * HALF + n * 16) = acc[ai][bj][m][n]; }
    }
};
}

__device__ __forceinline__ float wave_sum(float v) {
#pragma unroll
    for (int o = 1; o < 64; o <<= 1) v += __shfl_xor(v, o);
    return v;
}
__device__ __forceinline__ int win_map(int n) {
    if (n < 2048) return n;
    if (n < 3072) { const int j = n - 2048; return 2048 + (j >> 7) * 256 + (j & 127); }
    if (n < 4096) { const int j = n - 3072; return 2048 + (j >> 7) * 256 + 128 + (j & 127); }
    if (n < 4104) return 6728 + (n - 4096);
    if (n < 6664) return 4096 + (n - 4104);
    if (n < 6728) return 6656 + (n - 6664);
    return 6720 + (n - 6728);
}
template <bool MAP>
__device__ __forceinline__ void p0_transpose_item(const float* W, int K, int N, h16* WT, LAS float* scr, int item, int lane) {
    const int nblk = (N + 31) / 32, kb = item / nblk, nb = item % nblk, k0 = 64 * kb, n0 = 32 * nb;
    const int ncol = n0 + (lane & 31);
#pragma unroll 8
    for (int i = 0; i < 32; ++i) { const int kk = 2 * i + (lane >> 5); scr[kk * 33 + (lane & 31)] = (ncol < N) ? W[(size_t)(k0 + kk) * N + ncol] : 0.f; }
    asm volatile("s_waitcnt lgkmcnt(0)" ::: "memory");
    const int c = lane & 7;
#pragma unroll
    for (int j = 0; j < 4; ++j) { const int n = (lane >> 3) + 8 * j; const LAS float* s = scr + (8 * c) * 33 + n;
        u32x4 o; o.x = pkh(s[0 * 33], s[1 * 33]); o.y = pkh(s[2 * 33], s[3 * 33]); o.z = pkh(s[4 * 33], s[5 * 33]); o.w = pkh(s[6 * 33], s[7 * 33]);
        if (n0 + n < N) { const int row = MAP ? win_map(n0 + n) : (n0 + n); *(u32x4*)(WT + (size_t)row * K + k0 + 8 * c) = o; } }
    asm volatile("s_waitcnt lgkmcnt(0)" ::: "memory");
}
__device__ __forceinline__ int t5_bucket(int dist) {
    if (dist < 16) return dist;
    const int large = 16 + (int)(logf((float)dist * (1.0f / 16.0f)) / logf(8.0f) * 16.0f);
    return large < 31 ? large : 31;
}

__global__ void __launch_bounds__(512, 2) k_prologue(Args a) {
    extern __shared__ __attribute__((aligned(16))) unsigned char lds[];
    const int tid = threadIdx.x, lane = tid & 63, wave = tid >> 6;
    LAS float* scr = (LAS float*)((LAS unsigned char*)lds + wave * 16384);
    const int gw = blockIdx.x * 8 + wave, NGW = gridDim.x * 8;
    const float* w_in = a.in[2]; const float* w_out = a.in[5]; const float* w_ple = a.in[9]; const float* w_gate = a.in[10];
    h16* WIN = (h16*)(a.ws + WS_WIN); h16* WOUT = (h16*)(a.ws + WS_WOUT); h16* WGATE = (h16*)(a.ws + WS_WGATE); h16* WPLE = (h16*)(a.ws + WS_WPLE);
    constexpr int I_IN = (DM / 64) * ((NPROJ + 31) / 32), I_OUT = (DMIX / 64) * (DM / 32), I_G = (DM / 64) * (DM / 32), I_P = (DPLE / 64) * (DM / 32);
    constexpr int NITEMS = I_IN + I_OUT + I_G + I_P;
    for (int it = gw; it < NITEMS; it += NGW) {
        int r = it;
        if (r < I_IN) { p0_transpose_item<true>(w_in, DM, NPROJ, WIN, scr, r, lane); continue; } r -= I_IN;
        if (r < I_OUT) { p0_transpose_item<false>(w_out, DMIX, DM, WOUT, scr, r, lane); continue; } r -= I_OUT;
        if (r < I_G) { p0_transpose_item<false>(w_gate, DM, DM, WGATE, scr, r, lane); continue; } r -= I_G;
        p0_transpose_item<false>(w_ple, DPLE, DM, WPLE, scr, r, lane);
    }
    for (int r = gw; r < NPAD - NPROJ; r += NGW) { u32x4* p = (u32x4*)(WIN + (size_t)(NPROJ + r) * DM) + lane; p[0] = (u32x4){0, 0, 0, 0}; p[64] = (u32x4){0, 0, 0, 0}; }
    const float* x = a.in[0]; const float* p = a.in[1]; const float* g_in = a.in[6];
    h16* XN = (h16*)(a.ws + WS_XN); h16* P16 = (h16*)(a.ws + WS_P16);
    f32x4 gv[4];
#pragma unroll
    for (int j = 0; j < 4; ++j) gv[j] = ((const f32x4*)g_in)[lane + 64 * j];
    for (int m = gw; m < M; m += NGW) {
        const f32x4* xr = (const f32x4*)(x + (size_t)m * DM) + lane; f32x4 v[4]; float s = 0.f;
#pragma unroll
        for (int j = 0; j < 4; ++j) { v[j] = xr[64 * j]; s += (v[j].x * v[j].x + v[j].y * v[j].y) + (v[j].z * v[j].z + v[j].w * v[j].w); }
        const float rstd = 1.0f / sqrtf(wave_sum(s) * (1.0f / DM) + EPS);
        u32x2* o8 = (u32x2*)(XN + (size_t)m * DM) + lane;
#pragma unroll
        for (int j = 0; j < 4; ++j) { u32x2 w; w.x = pkh(v[j].x * rstd * gv[j].x, v[j].y * rstd * gv[j].y); w.y = pkh(v[j].z * rstd * gv[j].z, v[j].w * rstd * gv[j].w); o8[64 * j] = w; }
        const f32x4 pv = ((const f32x4*)(p + (size_t)m * DPLE))[lane]; u32x2 w; w.x = pkh(pv.x, pv.y); w.y = pkh(pv.z, pv.w);
        ((u32x2*)(P16 + (size_t)m * DPLE))[lane] = w;
    }
    if (blockIdx.x == 0) { const float* rb = a.in[8]; float* BT = (float*)(a.ws + WS_BT);
        for (int i = tid; i < 128 * 8; i += 512) { const int d = i >> 3, h = i & 7; BT[i] = (rb[t5_bucket(d) * 8 + h] - rb[31 * 8 + h]) * LOG2E; } }
}

__global__ void __launch_bounds__(512, 2) k_gemm_in(Args a) {
    extern __shared__ __attribute__((aligned(16))) unsigned char lds[];
    pg8::Gemm g{(const h16*)(a.ws + WS_XN), (const h16*)(a.ws + WS_WIN), M, NPAD, DM}; pg8::StaticOrder S; S.init(M, NPAD, gridDim.x, blockIdx.x);
    pg8::EpiProj E{a.ws, (unsigned char*)a.out, a.in[3]};
    pg8::gemm_phase<pg8::EpiProj, pg8::StaticOrder, true, true>((LAS unsigned char*)lds, g, S, E);
}
__global__ void __launch_bounds__(512, 2) k_gemm_out(Args a) {
    extern __shared__ __attribute__((aligned(16))) unsigned char lds[];
    { pg8::Gemm g{(const h16*)((unsigned char*)a.out), (const h16*)(a.ws + WS_WOUT), M, DM, DMIX}; pg8::StaticOrder S; S.init(M, DM, gridDim.x, blockIdx.x);
      pg8::EpiOut E{a.in[0], (float*)(a.ws + WS_H1), (h16*)(a.ws + WS_H1H)};
      pg8::gemm_phase<pg8::EpiOut, pg8::StaticOrder, false, true>((LAS unsigned char*)lds, g, S, E); }
    { pg8::Gemm g{(const h16*)(a.ws + WS_P16), (const h16*)(a.ws + WS_WPLE), M, DM, DPLE}; pg8::StaticOrder S; S.init(M, DM, gridDim.x, blockIdx.x);
      pg8::EpiF16 E{(h16*)(a.ws + WS_PB), DM};
      pg8::gemm_phase<pg8::EpiF16, pg8::StaticOrder, false, true>((LAS unsigned char*)lds, g, S, E); }
}
__global__ void __launch_bounds__(512, 2) k_gemm_gate(Args a) {
    extern __shared__ __attribute__((aligned(16))) unsigned char lds[];
    pg8::Gemm g{(const h16*)(a.ws + WS_H1H), (const h16*)(a.ws + WS_WGATE), M, DM, DM}; pg8::StaticOrder S; S.init(M, DM, gridDim.x, blockIdx.x);
    pg8::EpiF32 E{a.out, DM};
    pg8::gemm_phase<pg8::EpiF32, pg8::StaticOrder, false, true>((LAS unsigned char*)lds, g, S, E);
}
__global__ void __launch_bounds__(512) k_apply_gate(Args a) {
    float* h1 = (float*)(a.ws + WS_H1); const h16* pb = (const h16*)(a.ws + WS_PB); const float* G = a.out;
    for (size_t i = (size_t)blockIdx.x * 512 + threadIdx.x; i < (size_t)M * DM; i += (size_t)gridDim.x * 512) h1[i] = h1[i] + (float)pb[i] * sigmoidf_(G[i]);
}
__global__ void __launch_bounds__(512) k_final_norm(Args a) {
    const int lane = threadIdx.x & 63, gw = blockIdx.x * 8 + (threadIdx.x >> 6), NGW = gridDim.x * 8;
    const float* h2 = (const float*)(a.ws + WS_H1); const float* gf = a.in[11];
    f32x4 gv[4];
#pragma unroll
    for (int j = 0; j < 4; ++j) gv[j] = ((const f32x4*)gf)[lane + 64 * j];
    for (int m = gw; m < M; m += NGW) {
        const f32x4* xr = (const f32x4*)(h2 + (size_t)m * DM) + lane; f32x4 v[4]; float s = 0.f;
#pragma unroll
        for (int j = 0; j < 4; ++j) { v[j] = xr[64 * j]; s += (v[j].x * v[j].x + v[j].y * v[j].y) + (v[j].z * v[j].z + v[j].w * v[j].w); }
        const float rstd = 1.0f / sqrtf(wave_sum(s) * (1.0f / DM) + EPS);
        f32x4* o = (f32x4*)(a.out + (size_t)m * DM) + lane;
        const unsigned* flags = (const unsigned*)(a.ws + WS_FLAGS); float pen = 0.f;
#if DEBUG_CHECKS
        for (int i = 0; i < 12; ++i) if (i != 8 && __uint_as_float(flags[i]) > 1.0f) pen += (float)(1 << i);
#endif
#pragma unroll
        for (int j = 0; j < 4; ++j) o[64 * j] = v[j] * rstd * gv[j] + pen;
    }
}

__global__ void __launch_bounds__(512) k_mlstm_naive(Args a) {
    __shared__ float qs[64][128]; __shared__ float ks[64][128]; __shared__ float vs[64][32]; __shared__ float lis[64], lfs[64];
    const int tid = threadIdx.x, lane = tid & 63, w = tid >> 6, vq = lane >> 4, dg = lane & 15, vv = 4 * w + vq;
    const int bh = blockIdx.x >> 3, slice = blockIdx.x & 7, b = bh >> 2, h = bh & 3;
    const h16* MQ = (const h16*)((unsigned char*)a.out + DO_MQ); const h16* MK = (const h16*)((unsigned char*)a.out + DO_MK); const h16* MV = (const h16*)((unsigned char*)a.out + DO_MV);
    const float* GT = (const float*)(a.ws + WS_GATES); const float* cw = a.in[4];
    float* HR = (float*)(a.ws + WS_H1);
    float C[8], n[8]; float m = 0.f;
#pragma unroll
    for (int i = 0; i < 8; ++i) { C[i] = 0.f; n[i] = 0.f; }
    for (int c = 0; c < SEQ / 64; ++c) {
        const int t0 = c * 64;
        __syncthreads();
        for (int i = tid; i < 64 * 256; i += 512) { const int tok = i >> 8, ch = i & 255; const bool isk = ch >= 128; const int d = ch & 127;
            const int chg = (isk ? 512 : 0) + h * 128 + d; const h16* src = (isk ? MK : MQ) + h * 128 + d; float y = 0.f;
#pragma unroll
            for (int j = 0; j < 4; ++j) { const int t = t0 + tok - 3 + j; if (t >= 0) y += cw[j * 1024 + chg] * (float)src[(size_t)(b * SEQ + t) * 512]; }
            y = siluf_(y); if (isk) ks[tok][d] = y * 0.08838834764831845f; else qs[tok][d] = y; }
        for (int i = tid; i < 64 * 32; i += 512) { const int tok = i >> 5, v = i & 31; vs[tok][v] = (float)MV[(size_t)(b * SEQ + t0 + tok) * 1024 + h * 256 + slice * 32 + v]; }
        if (tid < 64) { lis[tid] = GT[(size_t)(b * SEQ + t0 + tid) * 8 + h]; lfs[tid] = GT[(size_t)(b * SEQ + t0 + tid) * 8 + 4 + h]; }
        __syncthreads();
        for (int s = 0; s < 64; ++s) {
            const float lf = lfs[s], li = lis[s]; const float mn = fmaxf(lf + m, li); const float fd = expf(lf + m - mn), iw = expf(li - mn); m = mn;
            const float vval = vs[s][vv] * iw; float ph = 0.f, pn = 0.f;
#pragma unroll
            for (int i = 0; i < 8; ++i) { const float kd = ks[s][dg * 8 + i], qd = qs[s][dg * 8 + i]; C[i] = fd * C[i] + kd * vval; n[i] = fd * n[i] + iw * kd; ph += C[i] * qd; pn += n[i] * qd; }
#pragma unroll
            for (int o = 1; o < 16; o <<= 1) { ph += __shfl_xor(ph, o); pn += __shfl_xor(pn, o); }
            if (dg == 0) HR[(size_t)(b * SEQ + t0 + s) * 1024 + h * 256 + slice * 32 + vv] = ph / fmaxf(fabsf(pn), expf(-m));
        }
    }
}
__global__ void __launch_bounds__(512) k_headnorm(Args a) {
    const int lane = threadIdx.x & 63, gw = blockIdx.x * 8 + (threadIdx.x >> 6), NGW = gridDim.x * 8;
    const float* HR = (const float*)(a.ws + WS_H1); const h16* MG = (const h16*)(a.ws + WS_MG); h16* MIX = (h16*)((unsigned char*)a.out); const float* mn = a.in[7];
    for (int it = gw; it < M * 4; it += NGW) { const int row = it >> 2, h = it & 3;
        const f32x4 v = ((const f32x4*)(HR + (size_t)row * 1024 + h * 256))[lane];
        const float ss = wave_sum(v.x * v.x + v.y * v.y + v.z * v.z + v.w * v.w); const float r = 1.0f / sqrtf(ss * (1.0f / 256.0f) + EPS);
        const f32x4 g = ((const f32x4*)(mn + h * 256))[lane]; const u32x2 mg = ((const u32x2*)(MG + (size_t)row * 1024 + h * 256))[lane];
        const h16x2 m01 = __builtin_bit_cast(h16x2, mg.x), m23 = __builtin_bit_cast(h16x2, mg.y);
        u32x2 o; o.x = pkh(v.x * r * g.x * (float)m01[0], v.y * r * g.y * (float)m01[1]); o.y = pkh(v.z * r * g.z * (float)m23[0], v.w * r * g.w * (float)m23[1]);
        ((u32x2*)(MIX + (size_t)row * DMIX + h * 256))[lane] = o; }
}

__global__ void __launch_bounds__(512) k_index_naive(Args a) {
    __shared__ unsigned keys[SEQ]; __shared__ float qf[512]; __shared__ unsigned hist[256]; __shared__ unsigned sh[4];
    const int tid = threadIdx.x, row = blockIdx.x, b = row >> 13, t = row & (SEQ - 1);
    const h16* IQ = (const h16*)(a.ws + WS_IQ); const h16* IK = (const h16*)(a.ws + WS_IK); const float* IW = (const float*)(a.ws + WS_IW);
    unsigned* MASK = (unsigned*)(a.ws + WS_MASK) + (size_t)row * 256;
    if (t < 256) { if (tid < 256) { const int lo = tid * 32; unsigned wv = 0; if (t >= lo + 31) wv = 0xffffffffu; else if (t >= lo) wv = (2u << (t - lo)) - 1u; MASK[tid] = wv; } return; }
    qf[tid] = (float)IQ[(size_t)row * 512 + tid];
    float wv[8];
#pragma unroll
    for (int hh = 0; hh < 8; ++hh) wv[hh] = IW[(size_t)row * 8 + hh];
    __syncthreads();
    for (int s = tid; s <= t; s += 512) {
        const u32x4* kr = (const u32x4*)(IK + (size_t)(b * SEQ + s) * 64); float dd[8];
#pragma unroll
        for (int hh = 0; hh < 8; ++hh) dd[hh] = 0.f;
#pragma unroll 1
        for (int j = 0; j < 8; ++j) { const h16x8 q8 = ((const h16x8*)kr)[j]; float k8[8];
#pragma unroll
            for (int i = 0; i < 8; ++i) k8[i] = (float)q8[i];
#pragma unroll
            for (int hh = 0; hh < 8; ++hh)
#pragma unroll
                for (int i = 0; i < 8; ++i) dd[hh] += qf[hh * 64 + 8 * j + i] * k8[i]; }
        float sc = 0.f;
#pragma unroll
        for (int hh = 0; hh < 8; ++hh) sc += wv[hh] * fmaxf(dd[hh], 0.f);
        sc += 0.0f;
        const unsigned u = __float_as_uint(sc); keys[s] = (u & 0x80000000u) ? ~u : (u | 0x80000000u);
    }
    unsigned prefix = 0; int krem = 256; unsigned neq = 0;
    for (int pass = 0; pass < 4; ++pass) { const int shift = 24 - 8 * pass;
        if (tid < 256) hist[tid] = 0;
        __syncthreads();
        for (int s = tid; s <= t; s += 512) { const unsigned k = keys[s]; if (pass == 0 || (k >> (shift + 8)) == prefix) atomicAdd(&hist[(k >> shift) & 255u], 1u); }
        __syncthreads();
        if (tid == 0) { int cum = 0; int d = 255; for (; d > 0; --d) { const int c = (int)hist[d]; if (cum + c >= krem) break; cum += c; } sh[0] = (unsigned)d; sh[1] = (unsigned)(krem - cum); sh[2] = hist[d]; }
        __syncthreads();
        prefix = (prefix << 8) | sh[0]; krem = (int)sh[1]; neq = sh[2];
        __syncthreads();
    }
    const unsigned tau = prefix; int idx_lim = SEQ;
    if ((int)neq != krem) { if (tid == 0) { int cnt = 0, lim = 0; for (int s = 0; s <= t; ++s) if (keys[s] == tau) { if (++cnt == krem) { lim = s; break; } } sh[3] = (unsigned)lim; }
        __syncthreads(); idx_lim = (int)sh[3]; }
    if (tid < 256) { unsigned wv2 = 0; const int lo = tid * 32;
        for (int i = 0; i < 32; ++i) { const int s = lo + i; if (s <= t) { const unsigned k = keys[s]; if (k > tau || (k == tau && s <= idx_lim)) wv2 |= 1u << i; } }
        MASK[tid] = wv2; }
}

__global__ void __launch_bounds__(512) k_attn_naive(Args a) {
    const int tid = threadIdx.x, lane = tid & 63, h = tid >> 6, row = blockIdx.x, b = row >> 13, t = row & (SEQ - 1);
    const h16* AQ = (const h16*)(a.ws + WS_AQ); const h16* AK = (const h16*)(a.ws + WS_AK); const h16* AV = (const h16*)(a.ws + WS_AV); const h16* AZ = (const h16*)(a.ws + WS_AZ);
    const unsigned* MASK = (const unsigned*)(a.ws + WS_MASK) + (size_t)row * 256; const float* BT = (const float*)(a.ws + WS_BT);
    h16* MIX = (h16*)((unsigned char*)a.out);
    const float q = (float)AQ[(size_t)row * 512 + h * 64 + lane];
    float mx = -1e30f, l = 0.f, o = 0.f;
    const int nw = (t >> 5) + 1;
    for (int w = 0; w < nw; ++w) { unsigned word = MASK[w];
        while (word) { const int bit = __builtin_ctz(word); word &= word - 1; const int s = w * 32 + bit;
            const size_t kr = (size_t)(b * SEQ + s) * 512 + h * 64 + lane;
            const float kv = (float)AK[kr], vv = (float)AV[kr];
            const int dist = t - s; const float x = wave_sum(q * kv) + BT[(dist < 127 ? dist : 127) * 8 + h];
            const float mn = fmaxf(mx, x); const float f = exp2f(mx - mn), p = exp2f(x - mn); l = l * f + p; o = o * f + p * vv; mx = mn; } }
    const float r = o / l * (float)AZ[(size_t)row * 512 + h * 64 + lane];
    MIX[(size_t)row * DMIX + 1024 + h * 64 + lane] = (h16)r;
}


__device__ __forceinline__ void flag_err(unsigned* flags, int idx, float ref, float got) {
    const float e = fabsf(ref - got) / (0.03f + 0.02f * fabsf(ref));
    atomicMax(&flags[idx], __float_as_uint(e == e ? e : 1e30f));
}
__global__ void __launch_bounds__(512) k_check_proj(Args a) {
    __shared__ float u[1024]; __shared__ float red[8];
    const int tid = threadIdx.x, lane = tid & 63, wave = tid >> 6; const int r = blockIdx.x;
    unsigned* flags = (unsigned*)(a.ws + WS_FLAGS);
    const float* x = a.in[0] + (size_t)r * DM; const float* g = a.in[6]; const float* W = a.in[2]; const float* bg = a.in[3];
    float s = 0.f; for (int k = tid; k < DM; k += 512) s += x[k] * x[k];
    s = wave_sum(s); if (lane == 0) red[wave] = s; __syncthreads();
    float tot = 0.f; for (int w = 0; w < 8; ++w) tot += red[w];
    const float rstd = 1.0f / sqrtf(tot / DM + EPS);
    for (int k = tid; k < DM; k += 512) u[k] = x[k] * rstd * g[k];
    __syncthreads();
    const h16* MQ = (const h16*)((unsigned char*)a.out + DO_MQ); const h16* MK = (const h16*)((unsigned char*)a.out + DO_MK); const h16* MV = (const h16*)((unsigned char*)a.out + DO_MV);
    const h16* MG = (const h16*)(a.ws + WS_MG); const h16* AQ = (const h16*)(a.ws + WS_AQ); const h16* AK = (const h16*)(a.ws + WS_AK); const h16* AV = (const h16*)(a.ws + WS_AV); const h16* AZ = (const h16*)(a.ws + WS_AZ);
    const h16* IQ = (const h16*)(a.ws + WS_IQ); const h16* IK = (const h16*)(a.ws + WS_IK); const float* IW = (const float*)(a.ws + WS_IW); const float* GT = (const float*)(a.ws + WS_GATES);
    for (int c = tid; c < NPROJ; c += 512) {
        float d = 0.f; for (int k = 0; k < DM; ++k) d += u[k] * W[(size_t)k * NPROJ + c];
        if (c < 512) flag_err(flags, 0, d, (float)MQ[(size_t)r * 512 + c]);
        else if (c < 1024) flag_err(flags, 0, d, (float)MK[(size_t)r * 512 + c - 512]);
        else if (c < 2048) flag_err(flags, 0, d, (float)MV[(size_t)r * 1024 + c - 1024]);
        else if (c < 3072) { float z = 0.f; for (int k = 0; k < DM; ++k) z += u[k] * W[(size_t)k * NPROJ + c + 1024];
            flag_err(flags, 1, sigmoidf_(d) * siluf_(z), (float)MG[(size_t)r * 1024 + c - 2048]); }
        else if (c < 4096) {}
        else if (c < 4100) flag_err(flags, 3, d + bg[c - 4096], GT[(size_t)r * 8 + c - 4096]);
        else if (c < 4104) { const float gg = d + bg[c - 4096]; flag_err(flags, 3, fminf(gg, 0.f) - log1pf(expf(-fabsf(gg))), GT[(size_t)r * 8 + c - 4096]); }
        else if (c < 4616) flag_err(flags, 2, d * C2, (float)AQ[(size_t)r * 512 + c - 4104]);
        else if (c < 5128) flag_err(flags, 2, d, (float)AK[(size_t)r * 512 + c - 4616]);
        else if (c < 5640) flag_err(flags, 2, d, (float)AV[(size_t)r * 512 + c - 5128]);
        else if (c < 6152) flag_err(flags, 2, siluf_(d), (float)AZ[(size_t)r * 512 + c - 5640]);
        else if (c < 6664) flag_err(flags, 3, d * 0.125f, (float)IQ[(size_t)r * 512 + c - 6152]);
        else if (c < 6728) flag_err(flags, 3, d, (float)IK[(size_t)r * 64 + c - 6664]);
        else flag_err(flags, 3, d * 0.35355339059327373f, IW[(size_t)r * 8 + c - 6728]);
    }
}
__global__ void __launch_bounds__(512) k_check_out(Args a) {
    __shared__ float mx[1536]; __shared__ float pr[256]; __shared__ float h1row[1024]; __shared__ float erow[1024];
    const int tid = threadIdx.x; const int i = blockIdx.x; const int r = i * 128 + ((i * 37) & 127);
    unsigned* flags = (unsigned*)(a.ws + WS_FLAGS);
    const h16* MIX = (const h16*)((unsigned char*)a.out) + (size_t)r * DMIX; const float* p = a.in[1] + (size_t)r * DPLE;
    for (int k = tid; k < DMIX; k += 512) mx[k] = (float)MIX[k];
    if (tid < 256) pr[tid] = p[tid];
    __syncthreads();
    const float* Wo = a.in[5]; const float* Wp = a.in[9]; const float* x = a.in[0] + (size_t)r * DM;
    const float* H1 = (const float*)(a.ws + WS_H1) + (size_t)r * DM; const h16* H1H = (const h16*)(a.ws + WS_H1H) + (size_t)r * DM; const h16* PB = (const h16*)(a.ws + WS_PB) + (size_t)r * DM;
    for (int c = tid; c < DM; c += 512) {
        float d = x[c]; for (int k = 0; k < DMIX; ++k) d += mx[k] * Wo[(size_t)k * DM + c];
        flag_err(flags, 4, d, H1[c]); flag_err(flags, 4, d, (float)H1H[c]);
        float e = 0.f; for (int k = 0; k < DPLE; ++k) e += pr[k] * Wp[(size_t)k * DM + c];
        flag_err(flags, 5, e, (float)PB[c]);
        h1row[c] = d; erow[c] = e;
    }
    __syncthreads();
    const float* Wg = a.in[10]; float* DBG = (float*)(a.ws + WS_DBG) + (size_t)i * DM;
    for (int c = tid; c < DM; c += 512) { float gsum = 0.f; for (int k = 0; k < DM; ++k) gsum += h1row[k] * Wg[(size_t)k * DM + c];
        DBG[c] = h1row[c] + erow[c] * sigmoidf_(gsum); }
    if (tid < 64) { float s1 = 0.f, s2 = 0.f; for (int k = tid; k < 1024; k += 64) s1 += mx[k] * mx[k]; for (int k = 1024 + tid; k < 1536; k += 64) s2 += mx[k] * mx[k];
        s1 = wave_sum(s1) / 1024.f; s2 = wave_sum(s2) / 512.f;
        if (tid == 0) { if (!(s1 > 0.02f && s1 < 0.4f)) atomicMax(&flags[7], __float_as_uint(2.0f)); if (!(s2 > 0.0003f && s2 < 0.05f)) atomicMax(&flags[8], __float_as_uint(2.0f)); } }
}
__global__ void __launch_bounds__(512) k_check_h2(Args a) {
    const int tid = threadIdx.x; const int i = blockIdx.x; const int r = i * 128 + ((i * 37) & 127);
    unsigned* flags = (unsigned*)(a.ws + WS_FLAGS);
    const float* H2 = (const float*)(a.ws + WS_H1) + (size_t)r * DM; const float* DBG = (const float*)(a.ws + WS_DBG) + (size_t)i * DM;
    for (int c = tid; c < DM; c += 512) flag_err(flags, 6, DBG[c], H2[c]);
}

__global__ void __launch_bounds__(512) k_check_mlstm(Args a) {
    __shared__ float qt[128]; __shared__ float wgt[SEQ]; __shared__ float red[16]; __shared__ float F[SEQ];
    const int tid = threadIdx.x, lane = tid & 63, wave = tid >> 6;
    const int ti = blockIdx.x & 7;
    const int t = ti == 0 ? 65 : ti == 1 ? 500 : ti == 2 ? 1000 : ti == 3 ? 2047 : ti == 4 ? 2048 : ti == 5 ? 4100 : ti == 6 ? 6000 : 8191, b = (blockIdx.x >> 3) & 1, h = (blockIdx.x >> 3) ? 3 : 0;
    unsigned* flags = (unsigned*)(a.ws + WS_FLAGS);
    const h16* MQ = (const h16*)((unsigned char*)a.out + DO_MQ); const h16* MK = (const h16*)((unsigned char*)a.out + DO_MK); const h16* MV = (const h16*)((unsigned char*)a.out + DO_MV);
    const float* GT = (const float*)(a.ws + WS_GATES); const float* cw = a.in[4]; const float* HR = (const float*)(a.ws + WS_H1);
    if (tid < 128) { float y = 0.f; for (int j = 0; j < 4; ++j) { const int tt = t - 3 + j; if (tt >= 0) y += cw[j * 1024 + h * 128 + tid] * (float)MQ[(size_t)(b * SEQ + tt) * 512 + h * 128 + tid]; } qt[tid] = siluf_(y); }
    if (tid == 0) { float acc = 0.f; for (int s = 0; s <= t; ++s) { acc += GT[(size_t)(b * SEQ + s) * 8 + 4 + h]; F[s] = acc; } }
    __syncthreads();
    const float Ft = F[t];
    __syncthreads();
    float mx = -1e30f;
    for (int s = tid; s <= t; s += 512) { float qk = 0.f;
#pragma unroll 1
        for (int d = 0; d < 128; ++d) { float y = 0.f;
#pragma unroll
            for (int j = 0; j < 4; ++j) { const int tt = s - 3 + j; if (tt >= 0) y += cw[j * 1024 + 512 + h * 128 + d] * (float)MK[(size_t)(b * SEQ + tt) * 512 + h * 128 + d]; }
            qk += qt[d] * siluf_(y) * 0.08838834764831845f; }
        const float Dts = Ft - F[s] + GT[(size_t)(b * SEQ + s) * 8 + h]; mx = fmaxf(mx, Dts); wgt[s] = qk; F[s] = Dts; }
    __syncthreads();
#pragma unroll
    for (int o = 1; o < 64; o <<= 1) mx = fmaxf(mx, __shfl_xor(mx, o));
    if (lane == 0) red[wave] = mx; __syncthreads();
    float mt = Ft; for (int w = 0; w < 8; ++w) mt = fmaxf(mt, red[w]);
    float ds = 0.f;
    for (int s = tid; s <= t; s += 512) { const float wv = wgt[s] * expf(F[s] - mt); wgt[s] = wv; ds += wv; }
    ds = wave_sum(ds); if (lane == 0) red[8 + wave] = ds; __syncthreads();
    float den = 0.f; for (int w = 0; w < 8; ++w) den += red[8 + w];
    den = fmaxf(fabsf(den), expf(-mt));
    if (tid < 256) { float num = 0.f; for (int s = 0; s <= t; ++s) num += wgt[s] * (float)MV[(size_t)(b * SEQ + s) * 1024 + h * 256 + tid];
        flag_err(flags, 9, num / den, HR[(size_t)(b * SEQ + t) * 1024 + h * 256 + tid]); }
}
__global__ void __launch_bounds__(512) k_check_dsa(Args a) {
    __shared__ float sc[SEQ]; __shared__ float qf[512]; __shared__ int sel[256]; __shared__ int nsel; __shared__ float lg[8][256]; __shared__ float hm[8], hs[8];
    const int tid = threadIdx.x; const int ti = blockIdx.x & 7;
    const int t = ti == 0 ? 0 : ti == 1 ? 100 : ti == 2 ? 255 : ti == 3 ? 256 : ti == 4 ? 300 : ti == 5 ? 1000 : ti == 6 ? 5000 : 8191, b = blockIdx.x >> 3, row = b * SEQ + t;
    unsigned* flags = (unsigned*)(a.ws + WS_FLAGS);
    const h16* IQ = (const h16*)(a.ws + WS_IQ); const h16* IK = (const h16*)(a.ws + WS_IK); const float* IW = (const float*)(a.ws + WS_IW);
    const h16* AQ = (const h16*)(a.ws + WS_AQ); const h16* AK = (const h16*)(a.ws + WS_AK); const h16* AV = (const h16*)(a.ws + WS_AV); const h16* AZ = (const h16*)(a.ws + WS_AZ);
    const h16* MIX = (const h16*)((unsigned char*)a.out); const float* rb = a.in[8];
    qf[tid] = (float)IQ[(size_t)row * 512 + tid]; if (tid == 0) nsel = 0;
    __syncthreads();
    for (int s = tid; s <= t; s += 512) { float tot = 0.f;
#pragma unroll 1
        for (int hh = 0; hh < 8; ++hh) { float d = 0.f;
#pragma unroll 4
            for (int j = 0; j < 64; ++j) d += qf[hh * 64 + j] * (float)IK[(size_t)(b * SEQ + s) * 64 + j]; tot += IW[(size_t)row * 8 + hh] * fmaxf(d, 0.f); }
        sc[s] = tot; }
    __syncthreads();
    for (int s = tid; s <= t; s += 512) { const float v = sc[s]; int rank = 0; for (int s2 = 0; s2 <= t; ++s2) { const float v2 = sc[s2]; rank += (v2 > v || (v2 == v && s2 < s)) ? 1 : 0; }
        if (rank < 256) { const int p = atomicAdd(&nsel, 1); sel[p] = s; } }
    __syncthreads();
    const int ns = nsel;
    qf[tid] = (float)AQ[(size_t)row * 512 + tid];
    __syncthreads();
    for (int i = tid; i < 8 * ns; i += 512) { const int hh = i / ns, j = i % ns, s = sel[j]; float d = 0.f;
        for (int k = 0; k < 64; ++k) d += qf[hh * 64 + k] * (float)AK[(size_t)(b * SEQ + s) * 512 + hh * 64 + k];
        lg[hh][j] = d + rb[t5_bucket(t - s) * 8 + hh] * LOG2E; }
    __syncthreads();
    if (tid < 8) { float m = -1e30f; for (int j = 0; j < ns; ++j) m = fmaxf(m, lg[tid][j]); float ssum = 0.f; for (int j = 0; j < ns; ++j) ssum += exp2f(lg[tid][j] - m); hm[tid] = m; hs[tid] = ssum; }
    __syncthreads();
    { const int hh = tid >> 6, d = tid & 63; float o = 0.f; for (int j = 0; j < ns; ++j) o += exp2f(lg[hh][j] - hm[hh]) * (float)AV[(size_t)(b * SEQ + sel[j]) * 512 + hh * 64 + d];
      const float ref = o / hs[hh] * (float)AZ[(size_t)row * 512 + tid];
      const float got = (float)MIX[(size_t)row * DMIX + 1024 + tid];
      const float e = fabsf(ref - got) / (0.003f + 0.02f * fabsf(ref)); atomicMax(&flags[10], __float_as_uint(e == e ? e : 1e30f)); }
}

__global__ void __launch_bounds__(256) k_check_headnorm(Args a) {
    __shared__ float red[4];
    const int tid = threadIdx.x, lane = tid & 63, wave = tid >> 6, row = blockIdx.x >> 2, h = blockIdx.x & 3;
    unsigned* flags = (unsigned*)(a.ws + WS_FLAGS);
    const float* HR = (const float*)(a.ws + WS_H1) + (size_t)row * 1024 + h * 256; const h16* MG = (const h16*)(a.ws + WS_MG) + (size_t)row * 1024 + h * 256;
    const h16* MIX = (const h16*)((unsigned char*)a.out) + (size_t)row * DMIX + h * 256; const float* mn = a.in[7] + h * 256;
    const float v = HR[tid]; float s = wave_sum(v * v); if (lane == 0) red[wave] = s; __syncthreads();
    const float tot = red[0] + red[1] + red[2] + red[3];
    const float ref = v / sqrtf(tot / 256.f + EPS) * mn[tid] * (float)MG[tid];
    const float got = (float)MIX[tid]; const float e = fabsf(ref - got) / (0.003f + 0.01f * fabsf(ref)); atomicMax(&flags[11], __float_as_uint(e == e ? e : 1e30f));
    if (!(e <= 1.0f)) { atomicAdd(&flags[20], 1u); atomicMax(&flags[21], 65535u - (unsigned)blockIdx.x); atomicMax(&flags[22], (unsigned)blockIdx.x); }
}

__global__ void __launch_bounds__(256) k_headnorm2(Args a) {
    __shared__ float red[4];
    const int tid = threadIdx.x, lane = tid & 63, wave = tid >> 6, row = blockIdx.x >> 2, h = blockIdx.x & 3;
    const float* HR = (const float*)(a.ws + WS_H1) + (size_t)row * 1024 + h * 256; const h16* MG = (const h16*)(a.ws + WS_MG) + (size_t)row * 1024 + h * 256;
    h16* MIX = (h16*)((unsigned char*)a.out) + (size_t)row * DMIX + h * 256; const float* mn = a.in[7] + h * 256;
    const float v = HR[tid]; float s = wave_sum(v * v); if (lane == 0) red[wave] = s; __syncthreads();
    const float tot = red[0] + red[1] + red[2] + red[3];
    MIX[tid] = (h16)(v / sqrtf(tot / 256.f + EPS) * mn[tid] * (float)MG[tid]);
}

extern "C" void kernel_launch(void* const* d_in, const int* in_sizes, int n_in, void* d_out, int out_size, void* d_ws, size_t ws_size, hipStream_t stream) {
    static int ok = 0;
    if (ok == 0) {
        if (n_in != 12 || in_sizes[0] != M * DM || out_size != M * DM || ws_size < WS_END) { fprintf(stderr, "kernel_launch: unexpected shapes (n_in %d, ws %zu)\n", n_in, ws_size); ok = -1; return; }
        hipFuncSetAttribute((const void*)k_prologue, hipFuncAttributeMaxDynamicSharedMemorySize, 131072);
        hipFuncSetAttribute((const void*)k_gemm_in, hipFuncAttributeMaxDynamicSharedMemorySize, 131072);
        hipFuncSetAttribute((const void*)k_gemm_out, hipFuncAttributeMaxDynamicSharedMemorySize, 131072);
        hipFuncSetAttribute((const void*)k_gemm_gate, hipFuncAttributeMaxDynamicSharedMemorySize, 131072);
        ok = 1;
    }
    if (ok < 0) return;
    Args a{};
    for (int i = 0; i < 12; ++i) a.in[i] = (const float*)d_in[i];
    a.out = (float*)d_out; a.ws = (unsigned char*)d_ws;
    hipMemsetAsync((char*)d_ws + WS_CTL, 0, CTL_ZERO_BYTES, stream);
    hipLaunchKernelGGL(k_prologue, dim3(256), dim3(512), 131072, stream, a);
    hipLaunchKernelGGL(k_gemm_in, dim3(256), dim3(512), 131072, stream, a);
#if DEBUG_CHECKS
    hipLaunchKernelGGL(k_check_proj, dim3(M), dim3(512), 0, stream, a);
#endif
    hipLaunchKernelGGL(k_index_naive, dim3(M), dim3(512), 0, stream, a);
    hipLaunchKernelGGL(k_mlstm_naive, dim3(64), dim3(512), 0, stream, a);
#if DEBUG_CHECKS
    hipLaunchKernelGGL(k_check_mlstm, dim3(16), dim3(512), 0, stream, a);
#endif
    hipLaunchKernelGGL(k_headnorm2, dim3(M * 4), dim3(256), 0, stream, a);
#if DEBUG_CHECKS
    hipLaunchKernelGGL(k_check_headnorm, dim3(M * 4), dim3(256), 0, stream, a);
#endif
    hipLaunchKernelGGL(k_attn_naive, dim3(M), dim3(512), 0, stream, a);
#if DEBUG_CHECKS
    hipLaunchKernelGGL(k_check_dsa, dim3(16), dim3(512), 0, stream, a);
#endif
    hipLaunchKernelGGL(k_gemm_out, dim3(256), dim3(512), 131072, stream, a);
#if DEBUG_CHECKS
    hipLaunchKernelGGL(k_check_out, dim3(128), dim3(512), 0, stream, a);
#endif
    hipLaunchKernelGGL(k_gemm_gate, dim3(256), dim3(512), 131072, stream, a);
    hipLaunchKernelGGL(k_apply_gate, dim3(2048), dim3(512), 0, stream, a);
#if DEBUG_CHECKS
    hipLaunchKernelGGL(k_check_h2, dim3(128), dim3(512), 0, stream, a);
#endif
    hipLaunchKernelGGL(k_final_norm, dim3(2048), dim3(512), 0, stream, a);
}
```

```cpp
#include <hip/hip_runtime.h>
#include <cstdio>
#include <cstdint>
#ifndef DEBUG_CHECKS
#define DEBUG_CHECKS 0
#endif

constexpr int BATCH = 2, SEQ = 8192, DM = 1024, M = BATCH * SEQ;
constexpr int NPROJ = 6736, NPAD = 6912;
constexpr int DMIX = 1536, DPLE = 256;
constexpr float EPS = 1e-6f;
constexpr float LOG2E = 1.4426950408889634f;
constexpr float C2 = 0.125f * LOG2E;

constexpr size_t MiB = 1u << 20;
constexpr size_t WS_CTL = 0, CTL_ZERO_BYTES = 1 * MiB;
constexpr size_t WS_WIN = 1 * MiB;
constexpr size_t WS_WOUT = 15 * MiB;
constexpr size_t WS_WGATE = 18 * MiB;
constexpr size_t WS_WPLE = 20 * MiB;
constexpr size_t WS_BT = 20 * MiB + 512 * 1024;
constexpr size_t WS_IK = 21 * MiB;
constexpr size_t WS_IW = 23 * MiB;
constexpr size_t WS_GATES = 23 * MiB + 512 * 1024;
constexpr size_t WS_P16 = 24 * MiB;
constexpr size_t WS_XN = 32 * MiB;
constexpr size_t WS_IQ = 64 * MiB;
constexpr size_t WS_MIX = 32 * MiB;
constexpr size_t WS_AQ = 80 * MiB, WS_AK = 96 * MiB, WS_AV = 112 * MiB, WS_AZ = 128 * MiB;
constexpr size_t WS_H1H = 80 * MiB;
constexpr size_t WS_PB = 112 * MiB;
constexpr size_t WS_MG = 144 * MiB;
constexpr size_t WS_MASK = 176 * MiB;
constexpr size_t WS_H1 = 192 * MiB;
constexpr size_t WS_END = 256 * MiB;
constexpr size_t WS_DBG = 14 * MiB + 512 * 1024;
constexpr size_t WS_FLAGS = 512 * 1024;
constexpr size_t DO_MQ = 0, DO_MK = 16 * MiB, DO_MV = 32 * MiB;
constexpr size_t DO_MIX = 0;

typedef _Float16 h16;
typedef _Float16 h16x2 __attribute__((ext_vector_type(2)));
typedef _Float16 h16x4 __attribute__((ext_vector_type(4)));
typedef _Float16 h16x8 __attribute__((ext_vector_type(8)));
typedef short s16x8 __attribute__((ext_vector_type(8)));
typedef float f32x4 __attribute__((ext_vector_type(4)));
typedef float f32x2 __attribute__((ext_vector_type(2)));
typedef unsigned u32x4 __attribute__((ext_vector_type(4)));
typedef unsigned u32x2 __attribute__((ext_vector_type(2)));
#define LAS __attribute__((address_space(3)))
#define GAS __attribute__((address_space(1)))

__device__ __forceinline__ unsigned pkh(float lo, float hi) { h16x2 v = {(h16)lo, (h16)hi}; return __builtin_bit_cast(unsigned, v); }
__device__ __forceinline__ float sigmoidf_(float x) { return 1.0f / (1.0f + __expf(-x)); }
__device__ __forceinline__ float siluf_(float x) { return x / (1.0f + __expf(-x)); }
__device__ __forceinline__ float h2f(unsigned short b) { return (float)__builtin_bit_cast(h16, b); }

struct Args { const float* in[12]; float* out; unsigned char* ws; int ph_lo, ph_hi; };

namespace pg8 {
constexpr int BM = 256, BK = 64, HALF = 128, HTB = HALF * BK * 2, STAGE_BYTES = 8 * HTB, NXCD = 8, WGM = 8;
__host__ __device__ __forceinline__ int lds_byte(int r, int c) { const int st = (r >> 4) * 2 + (c >> 5), rr = r & 15, cc = c & 31, ob = rr * 64 + cc * 2; return st * 1024 + (ob ^ (((ob >> 9) & 1) << 5)); }
__host__ __device__ __forceinline__ void stage_rc(int b, int& R, int& C) { const int st = b / 1024, sb = b % 1024, swz = sb ^ (((sb >> 9) & 1) << 5); R = (st >> 1) * 16 + swz / 64; C = (st & 1) * 32 + (swz % 64) / 2; }
__host__ __device__ __forceinline__ int perm32(int rho) { const int n = rho >> 4, i = rho & 15; return 8 * (i >> 2) + 4 * n + (i & 3); }

struct Unit { int pm, pn; };
struct Gemm { const h16* A; const h16* Bt; int M, N, K; };

struct StaticOrder {
    int nM, nN, nwg, G, c;
    __host__ __device__ void init(int M_, int N_, int G_, int c_) { nM = M_ / BM; nN = N_ / BM; nwg = nM * nN; G = G_; c = c_; }
    __host__ __device__ bool next(int i, Unit& u) const {
        const long L = (long)i * G + c; if (L >= nwg) return false;
        int wgid = (int)L; { const int q = nwg / NXCD, r = nwg % NXCD, xcd = wgid % NXCD, off = wgid / NXCD; wgid = (xcd < r ? xcd * (q + 1) : r * (q + 1) + (xcd - r) * q) + off; }
        const int nig = WGM * nN, gid = wgid / nig, fm = gid * WGM, gsz = (nM - fm) < WGM ? (nM - fm) : WGM;
        u.pm = fm + ((wgid % nig) % gsz); u.pn = (wgid % nig) / gsz; return true;
    }
};

template <class Epi, class Sched, bool ALIGN_EPI = false, bool SP2 = false>
__device__ __forceinline__ void gemm_phase(LAS unsigned char* lds, const Gemm g, const Sched& S, const Epi& E) {
    const int tid = threadIdx.x, wid = __builtin_amdgcn_readfirstlane(tid >> 6), lane = tid & 63, wr = wid >> 2, wc = wid & 3, fr = lane & 15, fq = lane >> 4;
    const int K = g.K, nt = K / BK;
    unsigned voffA[2], voffB[2];
#pragma unroll
    for (int i = 0; i < 2; ++i) { int R, C; stage_rc(tid * 16 + i * 8192, R, C); const int Rb = Epi::PERM ? ((R & ~31) + perm32(R & 31)) : R;
        voffA[i] = (unsigned)(R * K + C) * 2u; voffB[i] = (unsigned)(Rb * K + C) * 2u; }
    const size_t kstep = (size_t)(BK * 2);
    const size_t hstep = (size_t)HALF * K * 2;
    const size_t tstep = 2 * hstep;
    const unsigned ldsw = (unsigned)wid * 1024u;
    const int aoff = lds_byte(wr * 64 + fr, fq * 8), boff = lds_byte(wc * 32 + fr, fq * 8);
#define PG8_SA(b, h) (((b) * 2 + (h)) * HTB)
#define PG8_SB(b, h) ((4 + (b) * 2 + (h)) * HTB)
#define PG8_STAGE(bufoff, gbase, voff) do { _Pragma("unroll") for (int _i = 0; _i < 2; ++_i) \
        __builtin_amdgcn_global_load_lds((const unsigned*)((const char*)(gbase) + (voff)[_i]), (LAS unsigned*)(lds + (bufoff) + ldsw + _i * 8192), 16, 0, 0); } while (0)
#define PG8_LDA(dst, b, h) do { _Pragma("unroll") for (int m = 0; m < 4; ++m) _Pragma("unroll") for (int k = 0; k < 2; ++k) dst[m][k] = *(const LAS h16x8*)(lds + PG8_SA(b, h) + aoff + m * 2048 + k * 1024); } while (0)
#define PG8_LDB(dst, b, h) do { _Pragma("unroll") for (int n = 0; n < 2; ++n) _Pragma("unroll") for (int k = 0; k < 2; ++k) dst[n][k] = *(const LAS h16x8*)(lds + PG8_SB(b, h) + boff + n * 2048 + k * 1024); } while (0)
#define PG8_MMA(ai, bj, At, Bt) do { __builtin_amdgcn_s_setprio(1); _Pragma("unroll") for (int m = 0; m < 4; ++m) _Pragma("unroll") for (int n = 0; n < 2; ++n) _Pragma("unroll") for (int k = 0; k < 2; ++k) \
        acc[ai][bj][m][n] = __builtin_amdgcn_mfma_f32_16x16x32_f16(Bt[n][k], At[m][k], acc[ai][bj][m][n], 0, 0, 0); __builtin_amdgcn_s_setprio(0); } while (0)
#define PG8_WAIT_V(n) asm volatile("s_waitcnt vmcnt(" #n ")" ::: "memory")
#define PG8_WAIT_L(n) asm volatile("s_waitcnt lgkmcnt(" #n ")" ::: "memory")
#define PG8_BAR __builtin_amdgcn_s_barrier()
#define PG8_SCHED __builtin_amdgcn_sched_barrier(0)
    Unit cur, nxt; int ui = 0;
    if (!S.next(0, cur)) return;
    f32x4 acc[2][2][4][2];
#pragma unroll
    for (int a = 0; a < 2; ++a)
#pragma unroll
        for (int b = 0; b < 2; ++b)
#pragma unroll
            for (int m = 0; m < 4; ++m)
#pragma unroll
                for (int n = 0; n < 2; ++n) acc[a][b][m][n] = (f32x4){0.f, 0.f, 0.f, 0.f};
    h16x8 At[4][2], B0[2][2], B1[2][2];
    const char* cA = (const char*)g.A + (size_t)cur.pm * tstep; const char* cB = (const char*)g.Bt + (size_t)cur.pn * tstep;
    if constexpr (SP2) {
        PG8_STAGE(PG8_SB(0, 0), cB, voffB); PG8_STAGE(PG8_SB(0, 1), cB + hstep, voffB); PG8_STAGE(PG8_SA(0, 0), cA, voffA); PG8_STAGE(PG8_SA(0, 1), cA + hstep, voffA);
        if (wr == 1) PG8_BAR;
        PG8_WAIT_V(2); PG8_BAR;
        PG8_STAGE(PG8_SB(1, 0), cB + kstep, voffB); PG8_STAGE(PG8_SA(1, 0), cA + kstep, voffA); PG8_STAGE(PG8_SB(1, 1), cB + hstep + kstep, voffB);
        PG8_WAIT_V(6); PG8_BAR;
    } else {
        PG8_STAGE(PG8_SB(0, 0), cB, voffB); PG8_STAGE(PG8_SA(0, 0), cA, voffA); PG8_STAGE(PG8_SB(0, 1), cB + hstep, voffB); PG8_STAGE(PG8_SA(0, 1), cA + hstep, voffA);
        if (wr == 1) PG8_BAR;
        PG8_WAIT_V(4); PG8_BAR;
        PG8_STAGE(PG8_SB(1, 0), cB + kstep, voffB); PG8_STAGE(PG8_SA(1, 0), cA + kstep, voffA); PG8_STAGE(PG8_SB(1, 1), cB + hstep + kstep, voffB);
        PG8_WAIT_V(6); PG8_BAR;
    }
    for (;;) {
        const bool has_next = S.next(ui + 1, nxt);
        const char* nA = has_next ? (const char*)g.A + (size_t)nxt.pm * tstep : cA; const char* nB = has_next ? (const char*)g.Bt + (size_t)nxt.pn * tstep : cB;
        for (int t = 0; t < nt; t += 2) {
            const bool last = (t == nt - 2);
            const char* a1 = cA + (size_t)(t + 1) * kstep;
            const char* a2 = last ? nA : cA + (size_t)(t + 2) * kstep; const char* b2 = last ? nB : cB + (size_t)(t + 2) * kstep;
            const char* a3 = a2 + kstep; const char* b3 = b2 + kstep;
            if constexpr (SP2) {
            PG8_LDB(B0, 0, 0); PG8_LDB(B1, 0, 1); PG8_SCHED; PG8_LDA(At, 0, 0); PG8_STAGE(PG8_SA(1, 1), a1 + hstep, voffA);
            PG8_WAIT_V(8); PG8_WAIT_L(0); PG8_BAR; PG8_MMA(0, 0, At, B0); PG8_MMA(0, 1, At, B1); PG8_BAR; PG8_SCHED;
            PG8_LDA(At, 0, 1); PG8_STAGE(PG8_SB(0, 0), b2, voffB); PG8_STAGE(PG8_SB(0, 1), b2 + hstep, voffB); PG8_STAGE(PG8_SA(0, 0), a2, voffA);
            PG8_WAIT_V(8); PG8_WAIT_L(0); PG8_BAR; PG8_MMA(1, 0, At, B0); PG8_MMA(1, 1, At, B1); PG8_BAR; PG8_SCHED;
            PG8_LDB(B0, 1, 0); PG8_LDB(B1, 1, 1); PG8_SCHED; PG8_LDA(At, 1, 0); PG8_STAGE(PG8_SA(0, 1), a2 + hstep, voffA);
            PG8_WAIT_V(8); PG8_WAIT_L(0); PG8_BAR; PG8_MMA(0, 0, At, B0); PG8_MMA(0, 1, At, B1); PG8_BAR; PG8_SCHED;
            PG8_LDA(At, 1, 1); PG8_STAGE(PG8_SB(1, 0), b3, voffB); PG8_STAGE(PG8_SB(1, 1), b3 + hstep, voffB); PG8_STAGE(PG8_SA(1, 0), a3, voffA);
            PG8_WAIT_V(8); PG8_WAIT_L(0); PG8_BAR; PG8_MMA(1, 0, At, B0); PG8_MMA(1, 1, At, B1); PG8_BAR; PG8_SCHED;
            } else {
            PG8_LDB(B0, 0, 0); PG8_SCHED; PG8_LDA(At, 0, 0); PG8_STAGE(PG8_SA(1, 1), a1 + hstep, voffA);
            PG8_WAIT_L(8); PG8_BAR; PG8_WAIT_L(0); PG8_MMA(0, 0, At, B0); PG8_BAR; PG8_SCHED;
            PG8_LDB(B1, 0, 1); PG8_STAGE(PG8_SB(0, 0), b2, voffB);
            PG8_BAR; PG8_WAIT_L(0); PG8_MMA(0, 1, At, B1); PG8_BAR;
            PG8_LDA(At, 0, 1); PG8_STAGE(PG8_SA(0, 0), a2, voffA);
            PG8_BAR; PG8_WAIT_L(0); PG8_MMA(1, 0, At, B0); PG8_BAR; PG8_SCHED;
            PG8_STAGE(PG8_SB(0, 1), b2 + hstep, voffB);
            PG8_WAIT_V(6); PG8_BAR; PG8_MMA(1, 1, At, B1); PG8_BAR;
            PG8_LDB(B0, 1, 0); PG8_SCHED; PG8_LDA(At, 1, 0); PG8_STAGE(PG8_SA(0, 1), a2 + hstep, voffA);
            PG8_WAIT_L(8); PG8_BAR; PG8_WAIT_L(0); PG8_MMA(0, 0, At, B0); PG8_BAR; PG8_SCHED;
            PG8_LDB(B1, 1, 1); PG8_STAGE(PG8_SB(1, 0), b3, voffB);
            PG8_BAR; PG8_WAIT_L(0); PG8_MMA(0, 1, At, B1); PG8_BAR;
            PG8_LDA(At, 1, 1); PG8_STAGE(PG8_SA(1, 0), a3, voffA);
            PG8_BAR; PG8_WAIT_L(0); PG8_MMA(1, 0, At, B0); PG8_BAR; PG8_SCHED;
            PG8_STAGE(PG8_SB(1, 1), b3 + hstep, voffB);
            PG8_WAIT_V(6); PG8_BAR; PG8_MMA(1, 1, At, B1); PG8_BAR;
            }
        }
        if constexpr (ALIGN_EPI) { if (wr == 0) PG8_BAR; }
        E(acc, cur, wr, wc, fr, fq);
        if (!has_next) break;
#pragma unroll
        for (int a = 0; a < 2; ++a)
#pragma unroll
            for (int b = 0; b < 2; ++b)
#pragma unroll
                for (int m = 0; m < 4; ++m)
#pragma unroll
                    for (int n = 0; n < 2; ++n) acc[a][b][m][n] = (f32x4){0.f, 0.f, 0.f, 0.f};
        cur = nxt; cA = nA; cB = nB; ++ui;
        if constexpr (ALIGN_EPI) { if (wr == 1) PG8_BAR; }
    }
    PG8_WAIT_V(0);
    if constexpr (!ALIGN_EPI) { if (wr == 0) PG8_BAR; }
    PG8_BAR;
#undef PG8_SA
#undef PG8_SB
#undef PG8_STAGE
#undef PG8_LDA
#undef PG8_LDB
#undef PG8_MMA
#undef PG8_WAIT_V
#undef PG8_WAIT_L
#undef PG8_BAR
#undef PG8_SCHED
}

struct EpiProj {
    static constexpr bool PERM = true;
    unsigned char* ws; unsigned char* dout; const float* b_gate;
    __device__ __forceinline__ void operator()(const f32x4 (&acc)[2][2][4][2], const Unit& u, int wr, int wc, int fr, int fq) const {
        const int pn = u.pn; const int row0 = u.pm * BM + wr * 64 + fr; const int cw = wc * 32 + 8 * fq;
        if (pn >= 8 && pn < 16) {
            h16* base = (h16*)(ws + WS_MG) + (pn - 8) * 128 + cw;
#pragma unroll
            for (int ai = 0; ai < 2; ++ai)
#pragma unroll
                for (int m = 0; m < 4; ++m) { const f32x4 o0 = acc[ai][0][m][0], o1 = acc[ai][0][m][1], z0 = acc[ai][1][m][0], z1 = acc[ai][1][m][1];
                    float r[8];
#pragma unroll
                    for (int j = 0; j < 4; ++j) { r[j] = sigmoidf_(o0[j]) * siluf_(z0[j]); r[4 + j] = sigmoidf_(o1[j]) * siluf_(z1[j]); }
                    u32x4 w; w.x = pkh(r[0], r[1]); w.y = pkh(r[2], r[3]); w.z = pkh(r[4], r[5]); w.w = pkh(r[6], r[7]);
                    *(u32x4*)(base + (size_t)(row0 + ai * HALF + m * 16) * 1024) = w; }
            return;
        }
        if (pn == 26) {
            if (wc < 2) { h16* base = (h16*)(ws + WS_IK) + cw;
#pragma unroll
                for (int ai = 0; ai < 2; ++ai)
#pragma unroll
                    for (int m = 0; m < 4; ++m) { const f32x4 v0 = acc[ai][0][m][0], v1 = acc[ai][0][m][1];
                        u32x4 w; w.x = pkh(v0[0], v0[1]); w.y = pkh(v0[2], v0[3]); w.z = pkh(v1[0], v1[1]); w.w = pkh(v1[2], v1[3]);
                        *(u32x4*)(base + (size_t)(row0 + ai * HALF + m * 16) * 64) = w; }
            } else if (wc == 2 && fq == 0) { float* base = (float*)(ws + WS_IW); const float sc = 0.35355339059327373f;
#pragma unroll
                for (int ai = 0; ai < 2; ++ai)
#pragma unroll
                    for (int m = 0; m < 4; ++m) { float* p = base + (size_t)(row0 + ai * HALF + m * 16) * 8; *(f32x4*)p = acc[ai][0][m][0] * sc; *(f32x4*)(p + 4) = acc[ai][0][m][1] * sc; }
            } else if (wc == 2 && fq == 1) { float* base = (float*)(ws + WS_GATES); const f32x4 bi = *(const f32x4*)b_gate, bf = *(const f32x4*)(b_gate + 4);
#pragma unroll
                for (int ai = 0; ai < 2; ++ai)
#pragma unroll
                    for (int m = 0; m < 4; ++m) { float* p = base + (size_t)(row0 + ai * HALF + m * 16) * 8; *(f32x4*)p = acc[ai][0][m][0] + bi;
                        const f32x4 g = acc[ai][0][m][1] + bf; f32x4 lf;
#pragma unroll
                        for (int j = 0; j < 4; ++j) lf[j] = fminf(g[j], 0.f) - log1pf(expf(-fabsf(g[j])));
                        *(f32x4*)(p + 4) = lf; }
            }
            return;
        }
        h16* base; int pitch; int coff; float sc = 1.f; bool act = false;
        if (pn < 2)       { base = (h16*)(dout + DO_MQ); pitch = 512;  coff = pn * 256; }
        else if (pn < 4)  { base = (h16*)(dout + DO_MK); pitch = 512;  coff = (pn - 2) * 256; }
        else if (pn < 8)  { base = (h16*)(dout + DO_MV); pitch = 1024; coff = (pn - 4) * 256; }
        else if (pn < 18) { base = (h16*)(ws + WS_AQ);   pitch = 512;  coff = (pn - 16) * 256; sc = C2; }
        else if (pn < 20) { base = (h16*)(ws + WS_AK);   pitch = 512;  coff = (pn - 18) * 256; }
        else if (pn < 22) { base = (h16*)(ws + WS_AV);   pitch = 512;  coff = (pn - 20) * 256; }
        else if (pn < 24) { base = (h16*)(ws + WS_AZ);   pitch = 512;  coff = (pn - 22) * 256; act = true; }
        else              { base = (h16*)(ws + WS_IQ);   pitch = 512;  coff = (pn - 24) * 256; sc = 0.125f; }
#pragma unroll
        for (int ai = 0; ai < 2; ++ai)
#pragma unroll
            for (int m = 0; m < 4; ++m) { h16* rowp = base + (size_t)(row0 + ai * HALF + m * 16) * pitch + coff + cw;
#pragma unroll
                for (int bj = 0; bj < 2; ++bj) { f32x4 v0 = acc[ai][bj][m][0], v1 = acc[ai][bj][m][1];
                    if (act) {
#pragma unroll
                        for (int j = 0; j < 4; ++j) { v0[j] = siluf_(v0[j]); v1[j] = siluf_(v1[j]); } }
                    v0 = v0 * sc; v1 = v1 * sc;
                    u32x4 w; w.x = pkh(v0[0], v0[1]); w.y = pkh(v0[2], v0[3]); w.z = pkh(v1[0], v1[1]); w.w = pkh(v1[2], v1[3]);
                    *(u32x4*)(rowp + bj * HALF) = w; } }
    }
};
struct EpiF16 {
    static constexpr bool PERM = true;
    h16* O; int ldc;
    __device__ __forceinline__ void operator()(const f32x4 (&acc)[2][2][4][2], const Unit& u, int wr, int wc, int fr, int fq) const {
        const int row0 = u.pm * BM + wr * 64 + fr; const int col0 = u.pn * BM + wc * 32 + 8 * fq;
#pragma unroll
        for (int ai = 0; ai < 2; ++ai)
#pragma unroll
            for (int m = 0; m < 4; ++m) { h16* rowp = O + (size_t)(row0 + ai * HALF + m * 16) * ldc + col0;
#pragma unroll
                for (int bj = 0; bj < 2; ++bj) { const f32x4 v0 = acc[ai][bj][m][0], v1 = acc[ai][bj][m][1];
                    u32x4 w; w.x = pkh(v0[0], v0[1]); w.y = pkh(v0[2], v0[3]); w.z = pkh(v1[0], v1[1]); w.w = pkh(v1[2], v1[3]);
                    *(u32x4*)(rowp + bj * HALF) = w; } }
    }
};
struct EpiOut {
    static constexpr bool PERM = false;
    const float* x; float* h1; h16* h1h;
    __device__ __forceinline__ void operator()(const f32x4 (&acc)[2][2][4][2], const Unit& u, int wr, int wc, int fr, int fq) const {
        const int row0 = u.pm * BM + wr * 64 + fr; const int col0 = u.pn * BM + wc * 32 + 4 * fq;
#pragma unroll
        for (int ai = 0; ai < 2; ++ai)
#pragma unroll
            for (int m = 0; m < 4; ++m) { const size_t off = (size_t)(row0 + ai * HALF + m * 16) * DM + col0;
#pragma unroll
                for (int bj = 0; bj < 2; ++bj)
#pragma unroll
                    for (int n = 0; n < 2; ++n) { const size_t o = off + bj * HALF + n * 16; const f32x4 v = *(const f32x4*)(x + o) + acc[ai][bj][m][n];
                        *(f32x4*)(h1 + o) = v; u32x2 w; w.x = pkh(v[0], v[1]); w.y = pkh(v[2], v[3]); *(u32x2*)(h1h + o) = w; } }
    }
};
struct EpiF32 {
    static constexpr bool PERM = false;
    float* O; int ldc;
    __device__ __forceinline__ void operator()(const f32x4 (&acc)[2][2][4][2], const Unit& u, int wr, int wc, int fr, int fq) const {
        const int row0 = u.pm * BM + wr * 64 + fr; const int col0 = u.pn * BM + wc * 32 + 4 * fq;
#pragma unroll
        for (int ai = 0; ai < 2; ++ai)
#pragma unroll
            for (int m = 0; m < 4; ++m) { const size_t off = (size_t)(row0 + ai * HALF + m * 16) * ldc + col0;
#pragma unroll
                for (int bj = 0; bj < 2; ++bj)
#pragma unroll
                    for (int n = 0; n < 2; ++n) *(f32x4*)(O + off + bj * HALF + n * 16) = acc[ai][bj][m][n]; }
    }
};
}

__device__ __forceinline__ float wave_sum(float v) {
#pragma unroll
    for (int o = 1; o < 64; o <<= 1) v += __shfl_xor(v, o);
    return v;
}
__device__ __forceinline__ int win_map(int n) {
    if (n < 2048) return n;
    if (n < 3072) { const int j = n - 2048; return 2048 + (j >> 7) * 256 + (j & 127); }
    if (n < 4096) { const int j = n - 3072; return 2048 + (j >> 7) * 256 + 128 + (j & 127); }
    if (n < 4104) return 6728 + (n - 4096);
    if (n < 6664) return 4096 + (n - 4104);
    if (n < 6728) return 6656 + (n - 6664);
    return 6720 + (n - 6728);
}
template <bool MAP>
__device__ __forceinline__ void p0_transpose_item(const float* W, int K, int N, h16* WT, LAS float* scr, int item, int lane) {
    const int nblk = (N + 31) / 32, kb = item / nblk, nb = item % nblk, k0 = 64 * kb, n0 = 32 * nb;
    const int ncol = n0 + (lane & 31);
#pragma unroll 8
    for (int i = 0; i < 32; ++i) { const int kk = 2 * i + (lane >> 5); scr[kk * 33 + (lane & 31)] = (ncol < N) ? W[(size_t)(k0 + kk) * N + ncol] : 0.f; }
    asm volatile("s_waitcnt lgkmcnt(0)" ::: "memory");
    const int c = lane & 7;
#pragma unroll
    for (int j = 0; j < 4; ++j) { const int n = (lane >> 3) + 8 * j; const LAS float* s = scr + (8 * c) * 33 + n;
        u32x4 o; o.x = pkh(s[0 * 33], s[1 * 33]); o.y = pkh(s[2 * 33], s[3 * 33]); o.z = pkh(s[4 * 33], s[5 * 33]); o.w = pkh(s[6 * 33], s[7 * 33]);
        if (n0 + n < N) { const int row = MAP ? win_map(n0 + n) : (n0 + n); *(u32x4*)(WT + (size_t)row * K + k0 + 8 * c) = o; } }
    asm volatile("s_waitcnt lgkmcnt(0)" ::: "memory");
}
__device__ __forceinline__ int t5_bucket(int dist) {
    if (dist < 16) return dist;
    const int large = 16 + (int)(logf((float)dist * (1.0f / 16.0f)) / logf(8.0f) * 16.0f);
    return large < 31 ? large : 31;
}

#define XB_TMO      128
#define XB_XCNT(j)  (256  + 64 * (j))
#define XB_XSUB(j)  (1280 + 64 * (j))
#define XB_XGEN(j)  (2304 + 64 * (j))
#define XB_TOP      3328
#define XB_TOPGEN   3392
#define XCD_BAR_WORDS 3456
#define XB_SPIN_CAP (1u << 18)
__device__ __forceinline__ unsigned xb_ld(unsigned* p)              { return __hip_atomic_load(p, __ATOMIC_RELAXED, __HIP_MEMORY_SCOPE_AGENT); }
__device__ __forceinline__ unsigned xb_add(unsigned* p, unsigned v) { return __hip_atomic_fetch_add(p, v, __ATOMIC_RELAXED, __HIP_MEMORY_SCOPE_AGENT); }
__device__ __forceinline__ unsigned xb_xcc_id() { return (unsigned)__builtin_amdgcn_s_getreg((3 << 11) | 20) & 0xFu; }
#define XB_SPIN(cond, bar) do { unsigned _sp = 0; while (cond) { __builtin_amdgcn_s_sleep(1); \
    if ((++_sp & 255u) == 0u) { if (xb_ld(&(bar)[XB_TMO])) break; if (_sp > XB_SPIN_CAP) { atomicAdd(&(bar)[XB_TMO], 1u); break; } } } } while (0)
struct XcdBarrier { unsigned* bar; unsigned x; volatile LAS unsigned* st; };
__device__ __forceinline__ XcdBarrier xcd_barrier_post(unsigned* bar, volatile LAS unsigned* st) {
    XcdBarrier b; b.bar = bar; b.x = xb_xcc_id(); b.st = st;
    if (threadIdx.x == 0) (void)xb_add(&bar[XB_XCNT(b.x)], 1u);
    return b;
}
__device__ __forceinline__ void xcd_barrier_complete(unsigned* bar, unsigned x, unsigned& nloc, unsigned& nx) {
    const unsigned G = gridDim.x * gridDim.y * gridDim.z;
    unsigned sum, cnt, mine, sp = 0u;
    for (;;) {
        sum = 0u; cnt = 0u; mine = 0u;
#pragma unroll
        for (unsigned j = 0; j < 16; ++j) { const unsigned c = xb_ld(&bar[XB_XCNT(j)]); sum += c; cnt += (c > 0u) ? 1u : 0u; mine = (j == x) ? c : mine; }
        if (sum == G) break;
        __builtin_amdgcn_s_sleep(1);
        if ((++sp & 255u) == 0u) { if (xb_ld(&bar[XB_TMO])) break; if (sp > XB_SPIN_CAP) { atomicAdd(&bar[XB_TMO], 1u); break; } }
    }
    nloc = mine > 0u ? mine : 1u; nx = cnt > 0u ? cnt : 1u;
}
__device__ __forceinline__ void xcd_barrier(const XcdBarrier& b) {
    asm volatile("s_waitcnt vmcnt(0)" ::: "memory");
    __syncthreads();
    if (threadIdx.x == 0) {
        unsigned* bar = b.bar;
        __builtin_amdgcn_s_waitcnt(0);
        unsigned nloc = b.st[0], nx = b.st[1];
        if (nloc == 0u) { xcd_barrier_complete(bar, b.x, nloc, nx); b.st[0] = nloc; b.st[1] = nx; }
        const unsigned old = xb_add(&bar[XB_XSUB(b.x)], 1u);
        const unsigned gen = old / nloc;
        if (old + 1u == (gen + 1u) * nloc) {
            __builtin_amdgcn_fence(__ATOMIC_RELEASE, "agent");
            asm volatile("s_waitcnt vmcnt(0)" ::: "memory");
            const unsigned og = xb_add(&bar[XB_TOP], 1u);
            const unsigned tg = og / nx;
            if (og + 1u == (tg + 1u) * nx) xb_add(&bar[XB_TOPGEN], 1u);
            else XB_SPIN(xb_ld(&bar[XB_TOPGEN]) == tg, bar);
            __builtin_amdgcn_fence(__ATOMIC_ACQUIRE, "agent");
            xb_add(&bar[XB_XGEN(b.x)], 1u);
            asm volatile("s_waitcnt vmcnt(0)" ::: "memory");
        } else {
            XB_SPIN(xb_ld(&bar[XB_XGEN(b.x)]) == gen, bar);
            __builtin_amdgcn_fence(__ATOMIC_ACQUIRE, "agent");
            asm volatile("s_waitcnt vmcnt(0)" ::: "memory");
        }
    }
    __syncthreads();
}

constexpr int RING_BYTES = 131072, LDSCTL_OFF = RING_BYTES, LDS_BYTES = 147456;
constexpr int CW_BAR = 4096;

__device__ __forceinline__ void phase_prologue(const Args& a, LAS unsigned char* lds) {
    const int tid = threadIdx.x, lane = tid & 63, wave = tid >> 6;
    LAS float* scr = (LAS float*)(lds + wave * 16384);
    const int gw = blockIdx.x * 8 + wave, NGW = gridDim.x * 8;
    const float* w_in = a.in[2]; const float* w_out = a.in[5]; const float* w_ple = a.in[9]; const float* w_gate = a.in[10];
    h16* WIN = (h16*)(a.ws + WS_WIN); h16* WOUT = (h16*)(a.ws + WS_WOUT); h16* WGATE = (h16*)(a.ws + WS_WGATE); h16* WPLE = (h16*)(a.ws + WS_WPLE);
    constexpr int I_IN = (DM / 64) * ((NPROJ + 31) / 32), I_OUT = (DMIX / 64) * (DM / 32), I_G = (DM / 64) * (DM / 32), I_P = (DPLE / 64) * (DM / 32);
    constexpr int NITEMS = I_IN + I_OUT + I_G + I_P;
    for (int it = gw; it < NITEMS; it += NGW) {
        int r = it;
        if (r < I_IN) { p0_transpose_item<true>(w_in, DM, NPROJ, WIN, scr, r, lane); continue; } r -= I_IN;
        if (r < I_OUT) { p0_transpose_item<false>(w_out, DMIX, DM, WOUT, scr, r, lane); continue; } r -= I_OUT;
        if (r < I_G) { p0_transpose_item<false>(w_gate, DM, DM, WGATE, scr, r, lane); continue; } r -= I_G;
        p0_transpose_item<false>(w_ple, DPLE, DM, WPLE, scr, r, lane);
    }
    for (int r = gw; r < NPAD - NPROJ; r += NGW) { u32x4* p = (u32x4*)(WIN + (size_t)(NPROJ + r) * DM) + lane; p[0] = (u32x4){0, 0, 0, 0}; p[64] = (u32x4){0, 0, 0, 0}; }
    const float* x = a.in[0]; const float* p = a.in[1]; const float* g_in = a.in[6];
    h16* XN = (h16*)(a.ws + WS_XN); h16* P16 = (h16*)(a.ws + WS_P16);
    f32x4 gv[4];
#pragma unroll
    for (int j = 0; j < 4; ++j) gv[j] = ((const f32x4*)g_in)[lane + 64 * j];
    for (int m = gw; m < M; m += NGW) {
        const f32x4* xr = (const f32x4*)(x + (size_t)m * DM) + lane; f32x4 v[4]; float s = 0.f;
#pragma unroll
        for (int j = 0; j < 4; ++j) { v[j] = xr[64 * j]; s += (v[j].x * v[j].x + v[j].y * v[j].y) + (v[j].z * v[j].z + v[j].w * v[j].w); }
        const float rstd = 1.0f / sqrtf(wave_sum(s) * (1.0f / DM) + EPS);
        u32x2* o8 = (u32x2*)(XN + (size_t)m * DM) + lane;
#pragma unroll
        for (int j = 0; j < 4; ++j) { u32x2 w; w.x = pkh(v[j].x * rstd * gv[j].x, v[j].y * rstd * gv[j].y); w.y = pkh(v[j].z * rstd * gv[j].z, v[j].w * rstd * gv[j].w); o8[64 * j] = w; }
        const f32x4 pv = ((const f32x4*)(p + (size_t)m * DPLE))[lane]; u32x2 w; w.x = pkh(pv.x, pv.y); w.y = pkh(pv.z, pv.w);
        ((u32x2*)(P16 + (size_t)m * DPLE))[lane] = w;
    }
    if (blockIdx.x == 0) { const float* rb = a.in[8]; float* BT = (float*)(a.ws + WS_BT);
        for (int i = tid; i < 128 * 8; i += 512) { const int d = i >> 3, h = i & 7; BT[i] = (rb[t5_bucket(d) * 8 + h] - rb[31 * 8 + h]) * LOG2E; } }
}

__device__ __forceinline__ void phase_mlstm_naive(const Args& a, LAS unsigned char* lds, int blk) {
    LAS float* qs = (LAS float*)lds; LAS float* ks = (LAS float*)(lds + 32768); LAS float* vs = (LAS float*)(lds + 65536); LAS float* lis = (LAS float*)(lds + 73728); LAS float* lfs = (LAS float*)(lds + 73984);
    const int tid = threadIdx.x, lane = tid & 63, w = tid >> 6, vq = lane >> 4, dg = lane & 15, vv = 4 * w + vq;
    const int bh = blk >> 3, slice = blk & 7, b = bh >> 2, h = bh & 3;
    const h16* MQ = (const h16*)((unsigned char*)a.out + DO_MQ); const h16* MK = (const h16*)((unsigned char*)a.out + DO_MK); const h16* MV = (const h16*)((unsigned char*)a.out + DO_MV);
    const float* GT = (const float*)(a.ws + WS_GATES); const float* cw = a.in[4];
    float* HR = (float*)(a.ws + WS_H1);
    float C[8], n[8]; float m = 0.f;
#pragma unroll
    for (int i = 0; i < 8; ++i) { C[i] = 0.f; n[i] = 0.f; }
    for (int c = 0; c < SEQ / 64; ++c) {
        const int t0 = c * 64;
        __syncthreads();
        for (int i = tid; i < 64 * 256; i += 512) { const int tok = i >> 8, ch = i & 255; const bool isk = ch >= 128; const int d = ch & 127;
            const int chg = (isk ? 512 : 0) + h * 128 + d; const h16* src = (isk ? MK : MQ) + h * 128 + d; float y = 0.f;
#pragma unroll
            for (int j = 0; j < 4; ++j) { const int t = t0 + tok - 3 + j; if (t >= 0) y += cw[j * 1024 + chg] * (float)src[(size_t)(b * SEQ + t) * 512]; }
            y = siluf_(y); if (isk) ks[tok * 128 + d] = y * 0.08838834764831845f; else qs[tok * 128 + d] = y; }
        for (int i = tid; i < 64 * 32; i += 512) { const int tok = i >> 5, v = i & 31; vs[tok * 32 + v] = (float)MV[(size_t)(b * SEQ + t0 + tok) * 1024 + h * 256 + slice * 32 + v]; }
        if (tid < 64) { lis[tid] = GT[(size_t)(b * SEQ + t0 + tid) * 8 + h]; lfs[tid] = GT[(size_t)(b * SEQ + t0 + tid) * 8 + 4 + h]; }
        __syncthreads();
        for (int s = 0; s < 64; ++s) {
            const float lf = lfs[s], li = lis[s]; const float mn = fmaxf(lf + m, li); const float fd = expf(lf + m - mn), iw = expf(li - mn); m = mn;
            const float vval = vs[s * 32 + vv] * iw; float ph = 0.f, pn = 0.f;
#pragma unroll
            for (int i = 0; i < 8; ++i) { const float kd = ks[s * 128 + dg * 8 + i], qd = qs[s * 128 + dg * 8 + i]; C[i] = fd * C[i] + kd * vval; n[i] = fd * n[i] + iw * kd; ph += C[i] * qd; pn += n[i] * qd; }
#pragma unroll
            for (int o = 1; o < 16; o <<= 1) { ph += __shfl_xor(ph, o); pn += __shfl_xor(pn, o); }
            if (dg == 0) HR[(size_t)(b * SEQ + t0 + s) * 1024 + h * 256 + slice * 32 + vv] = ph / fmaxf(fabsf(pn), expf(-m));
        }
    }
    __syncthreads();
}

__device__ __forceinline__ void phase_headnorm(const Args& a, LAS unsigned char* lds) {
    LAS float* red = (LAS float*)lds;
    const int tid = threadIdx.x, lane = tid & 63, wave = tid >> 6, sub = tid >> 8, t2 = tid & 255;
    const float* HRb = (const float*)(a.ws + WS_H1); const h16* MGb = (const h16*)(a.ws + WS_MG); h16* MIXb = (h16*)((unsigned char*)a.out + DO_MIX); const float* mnb = a.in[7];
    for (int it = blockIdx.x * 2; it < M * 4; it += gridDim.x * 2) { const int pr = it + sub, row = pr >> 2, h = pr & 3;
        const float v = HRb[(size_t)row * 1024 + h * 256 + t2]; const float s = wave_sum(v * v);
        __syncthreads(); if (lane == 0) red[wave] = s; __syncthreads();
        const float tot = red[sub * 4] + red[sub * 4 + 1] + red[sub * 4 + 2] + red[sub * 4 + 3];
        MIXb[(size_t)row * DMIX + h * 256 + t2] = (h16)(v / sqrtf(tot / 256.f + EPS) * mnb[h * 256 + t2] * (float)MGb[(size_t)row * 1024 + h * 256 + t2]); }
    __syncthreads();
}

__device__ __forceinline__ void index_row_naive(const Args& a, LAS unsigned char* lds, int row) {
    LAS unsigned* keys = (LAS unsigned*)lds; LAS float* qf = (LAS float*)(lds + 32768); LAS unsigned* hist = (LAS unsigned*)(lds + 34816); LAS unsigned* sh = (LAS unsigned*)(lds + 35840);
    const int tid = threadIdx.x, b = row >> 13, t = row & (SEQ - 1);
    const h16* IQ = (const h16*)(a.ws + WS_IQ); const h16* IK = (const h16*)(a.ws + WS_IK); const float* IW = (const float*)(a.ws + WS_IW);
    unsigned* MASK = (unsigned*)(a.ws + WS_MASK) + (size_t)row * 256;
    if (t < 256) { if (tid < 256) { const int lo = tid * 32; unsigned wv = 0; if (t >= lo + 31) wv = 0xffffffffu; else if (t >= lo) wv = (2u << (t - lo)) - 1u; MASK[tid] = wv; } return; }
    __syncthreads();
    qf[tid] = (float)IQ[(size_t)row * 512 + tid];
    float wv[8];
#pragma unroll
    for (int hh = 0; hh < 8; ++hh) wv[hh] = IW[(size_t)row * 8 + hh];
    __syncthreads();
    for (int s = tid; s <= t; s += 512) {
        const h16x8* kr = (const h16x8*)(IK + (size_t)(b * SEQ + s) * 64); float dd[8];
#pragma unroll
        for (int hh = 0; hh < 8; ++hh) dd[hh] = 0.f;
#pragma unroll 1
        for (int j = 0; j < 8; ++j) { const h16x8 q8 = kr[j]; float k8[8];
#pragma unroll
            for (int i = 0; i < 8; ++i) k8[i] = (float)q8[i];
#pragma unroll
            for (int hh = 0; hh < 8; ++hh)
#pragma unroll
                for (int i = 0; i < 8; ++i) dd[hh] += qf[hh * 64 + 8 * j + i] * k8[i]; }
        float sc = 0.f;
#pragma unroll
        for (int hh = 0; hh < 8; ++hh) sc += wv[hh] * fmaxf(dd[hh], 0.f);
        sc += 0.0f;
        const unsigned u = __float_as_uint(sc); keys[s] = (u & 0x80000000u) ? ~u : (u | 0x80000000u);
    }
    unsigned prefix = 0; int krem = 256; unsigned neq = 0;
    for (int pass = 0; pass < 4; ++pass) { const int shift = 24 - 8 * pass;
        if (tid < 256) hist[tid] = 0;
        __syncthreads();
        for (int s = tid; s <= t; s += 512) { const unsigned k = keys[s]; if (pass == 0 || (k >> (shift + 8)) == prefix) __hip_atomic_fetch_add(hist + ((k >> shift) & 255u), 1u, __ATOMIC_RELAXED, __HIP_MEMORY_SCOPE_WORKGROUP); }
        __syncthreads();
        if (tid == 0) { int cum = 0; int d = 255; for (; d > 0; --d) { const int c = (int)hist[d]; if (cum + c >= krem) break; cum += c; } sh[0] = (unsigned)d; sh[1] = (unsigned)(krem - cum); sh[2] = hist[d]; }
        __syncthreads();
        prefix = (prefix << 8) | sh[0]; krem = (int)sh[1]; neq = sh[2];
        __syncthreads();
    }
    const unsigned tau = prefix; int idx_lim = SEQ;
    if ((int)neq != krem) { if (tid == 0) { int cnt = 0, lim = 0; for (int s = 0; s <= t; ++s) if (keys[s] == tau) { if (++cnt == krem) { lim = s; break; } } sh[3] = (unsigned)lim; }
        __syncthreads(); idx_lim = (int)sh[3]; }
    if (tid < 256) { unsigned wv2 = 0; const int lo = tid * 32;
        for (int i = 0; i < 32; ++i) { const int s = lo + i; if (s <= t) { const unsigned k = keys[s]; if (k > tau || (k == tau && s <= idx_lim)) wv2 |= 1u << i; } }
        MASK[tid] = wv2; }
}

__device__ __forceinline__ void attn_row_naive(const Args& a, int row) {
    const int tid = threadIdx.x, lane = tid & 63, h = tid >> 6, b = row >> 13, t = row & (SEQ - 1);
    const h16* AQ = (const h16*)(a.ws + WS_AQ); const h16* AK = (const h16*)(a.ws + WS_AK); const h16* AV = (const h16*)(a.ws + WS_AV); const h16* AZ = (const h16*)(a.ws + WS_AZ);
    const unsigned* MASK = (const unsigned*)(a.ws + WS_MASK) + (size_t)row * 256; const float* BT = (const float*)(a.ws + WS_BT);
    h16* MIX = (h16*)((unsigned char*)a.out + DO_MIX);
    const float q = (float)AQ[(size_t)row * 512 + h * 64 + lane];
    float mx = -1e30f, l = 0.f, o = 0.f;
    const int nw = (t >> 5) + 1;
    for (int w = 0; w < nw; ++w) { unsigned word = MASK[w];
        while (word) { const int bit = __builtin_ctz(word); word &= word - 1; const int s = w * 32 + bit;
            const size_t kr = (size_t)(b * SEQ + s) * 512 + h * 64 + lane;
            const float kv = (float)AK[kr], vv = (float)AV[kr];
            const int dist = t - s; const float x = wave_sum(q * kv) + BT[(dist < 127 ? dist : 127) * 8 + h];
            const float mn = fmaxf(mx, x); const float f = exp2f(mx - mn), p = exp2f(x - mn); l = l * f + p; o = o * f + p * vv; mx = mn; } }
    const float r = o / l * (float)AZ[(size_t)row * 512 + h * 64 + lane];
    MIX[(size_t)row * DMIX + 1024 + h * 64 + lane] = (h16)r;
}

__device__ __forceinline__ void phase_tail(const Args& a) {
    const int lane = threadIdx.x & 63, gw = blockIdx.x * 8 + (threadIdx.x >> 6), NGW = gridDim.x * 8;
    const float* H1 = (const float*)(a.ws + WS_H1); const h16* PB = (const h16*)(a.ws + WS_PB); const float* gf = a.in[11];
    f32x4 gv[4];
#pragma unroll
    for (int j = 0; j < 4; ++j) gv[j] = ((const f32x4*)gf)[lane + 64 * j];
    for (int m = gw; m < M; m += NGW) {
        const f32x4* hr = (const f32x4*)(H1 + (size_t)m * DM) + lane; const h16x4* pr = (const h16x4*)(PB + (size_t)m * DM) + lane; f32x4* o = (f32x4*)(a.out + (size_t)m * DM) + lane;
        f32x4 v[4]; float s = 0.f;
#pragma unroll
        for (int j = 0; j < 4; ++j) { const f32x4 hv = hr[64 * j], g = o[64 * j]; const h16x4 p4 = pr[64 * j];
            v[j].x = hv.x + (float)p4[0] * sigmoidf_(g.x); v[j].y = hv.y + (float)p4[1] * sigmoidf_(g.y); v[j].z = hv.z + (float)p4[2] * sigmoidf_(g.z); v[j].w = hv.w + (float)p4[3] * sigmoidf_(g.w);
            s += (v[j].x * v[j].x + v[j].y * v[j].y) + (v[j].z * v[j].z + v[j].w * v[j].w); }
        const float rstd = 1.0f / sqrtf(wave_sum(s) * (1.0f / DM) + EPS);
        float pen = 0.f;
#if DEBUG_CHECKS
        { const unsigned* flags = (const unsigned*)(a.ws + WS_FLAGS); for (int i = 0; i < 12; ++i) if (i != 8 && __uint_as_float(flags[i]) > 1.0f) pen += (float)(1 << i); }
#endif
#pragma unroll
        for (int j = 0; j < 4; ++j) o[64 * j] = v[j] * rstd * gv[j] + pen;
    }
}

constexpr int NPH = 7;
__global__ void __launch_bounds__(512, 2) fwd(Args a) {
    extern __shared__ __attribute__((aligned(16))) unsigned char lds_[];
    LAS unsigned char* lds = (LAS unsigned char*)lds_;
    volatile LAS unsigned* ctlw = (volatile LAS unsigned*)(lds + LDSCTL_OFF);
    const int tid = threadIdx.x;
    if (tid < 64) ctlw[tid] = 0u;
    __syncthreads();
    const int lo = a.ph_lo, hi = a.ph_hi;
    XcdBarrier bar; bar.bar = (unsigned*)(a.ws + WS_CTL) + CW_BAR; bar.x = 0; bar.st = nullptr;
    if (hi - lo > 1) bar = xcd_barrier_post((unsigned*)(a.ws + WS_CTL) + CW_BAR, ctlw + 8);
#define IN(k) (lo <= (k) && (k) < hi)
#define SEAM(k) do { if (IN(k) && IN((k) + 1)) xcd_barrier(bar); } while (0)
    if (IN(0)) phase_prologue(a, lds);
    SEAM(0);
    if (IN(1)) { pg8::Gemm g{(const h16*)(a.ws + WS_XN), (const h16*)(a.ws + WS_WIN), M, NPAD, DM}; pg8::StaticOrder S; S.init(M, NPAD, gridDim.x, blockIdx.x);
        pg8::EpiProj E{a.ws, (unsigned char*)a.out, a.in[3]};
        pg8::gemm_phase<pg8::EpiProj, pg8::StaticOrder, true, true>(lds, g, S, E); }
    SEAM(1);
    if (IN(2)) { for (int i = 0; (int)blockIdx.x + (int)gridDim.x * (i >> 1) < M / 2; ++i) { const int lowr = blockIdx.x + gridDim.x * (i >> 1); index_row_naive(a, lds, (i & 1) ? (M - 1 - lowr) : lowr); }
        __syncthreads();
        if (blockIdx.x < 64) phase_mlstm_naive(a, lds, blockIdx.x); }
    SEAM(2);
    if (IN(3)) { phase_headnorm(a, lds); for (int row = blockIdx.x; row < M; row += gridDim.x) attn_row_naive(a, row); }
    SEAM(3);
    if (IN(4)) {
        { pg8::Gemm g{(const h16*)((unsigned char*)a.out + DO_MIX), (const h16*)(a.ws + WS_WOUT), M, DM, DMIX}; pg8::StaticOrder S; S.init(M, DM, gridDim.x, blockIdx.x);
          pg8::EpiOut E{a.in[0], (float*)(a.ws + WS_H1), (h16*)(a.ws + WS_H1H)};
          pg8::gemm_phase<pg8::EpiOut, pg8::StaticOrder, false, true>(lds, g, S, E); }
        { pg8::Gemm g{(const h16*)(a.ws + WS_P16), (const h16*)(a.ws + WS_WPLE), M, DM, DPLE}; pg8::StaticOrder S; S.init(M, DM, gridDim.x, blockIdx.x);
          pg8::EpiF16 E{(h16*)(a.ws + WS_PB), DM};
          pg8::gemm_phase<pg8::EpiF16, pg8::StaticOrder, false, true>(lds, g, S, E); } }
    SEAM(4);
    if (IN(5)) { pg8::Gemm g{(const h16*)(a.ws + WS_H1H), (const h16*)(a.ws + WS_WGATE), M, DM, DM}; pg8::StaticOrder S; S.init(M, DM, gridDim.x, blockIdx.x);
        pg8::EpiF32 E{a.out, DM};
        pg8::gemm_phase<pg8::EpiF32, pg8::StaticOrder, false, true>(lds, g, S, E); }
    SEAM(5);
    if (IN(6)) phase_tail(a);
#undef IN
#undef SEAM
}
#if DEBUG_CHECKS
__device__ __forceinline__ void flag_err(unsigned* flags, int idx, float ref, float got) {
    const float e = fabsf(ref - got) / (0.03f + 0.02f * fabsf(ref));
    atomicMax(&flags[idx], __float_as_uint(e == e ? e : 1e30f));
}
__global__ void __launch_bounds__(512) k_check_proj(Args a) {
    __shared__ float u[1024]; __shared__ float red[8];
    const int tid = threadIdx.x, lane = tid & 63, wave = tid >> 6; const int r = blockIdx.x;
    unsigned* flags = (unsigned*)(a.ws + WS_FLAGS);
    const float* x = a.in[0] + (size_t)r * DM; const float* g = a.in[6]; const float* W = a.in[2]; const float* bg = a.in[3];
    float s = 0.f; for (int k = tid; k < DM; k += 512) s += x[k] * x[k];
    s = wave_sum(s); if (lane == 0) red[wave] = s; __syncthreads();
    float tot = 0.f; for (int w = 0; w < 8; ++w) tot += red[w];
    const float rstd = 1.0f / sqrtf(tot / DM + EPS);
    for (int k = tid; k < DM; k += 512) u[k] = x[k] * rstd * g[k];
    __syncthreads();
    const h16* MQ = (const h16*)((unsigned char*)a.out + DO_MQ); const h16* MK = (const h16*)((unsigned char*)a.out + DO_MK); const h16* MV = (const h16*)((unsigned char*)a.out + DO_MV);
    const h16* MG = (const h16*)(a.ws + WS_MG); const h16* AQ = (const h16*)(a.ws + WS_AQ); const h16* AK = (const h16*)(a.ws + WS_AK); const h16* AV = (const h16*)(a.ws + WS_AV); const h16* AZ = (const h16*)(a.ws + WS_AZ);
    const h16* IQ = (const h16*)(a.ws + WS_IQ); const h16* IK = (const h16*)(a.ws + WS_IK); const float* IW = (const float*)(a.ws + WS_IW); const float* GT = (const float*)(a.ws + WS_GATES);
    for (int c = tid; c < NPROJ; c += 512) {
        float d = 0.f; for (int k = 0; k < DM; ++k) d += u[k] * W[(size_t)k * NPROJ + c];
        if (c < 512) flag_err(flags, 0, d, (float)MQ[(size_t)r * 512 + c]);
        else if (c < 1024) flag_err(flags, 0, d, (float)MK[(size_t)r * 512 + c - 512]);
        else if (c < 2048) flag_err(flags, 0, d, (float)MV[(size_t)r * 1024 + c - 1024]);
        else if (c < 3072) { float z = 0.f; for (int k = 0; k < DM; ++k) z += u[k] * W[(size_t)k * NPROJ + c + 1024];
            flag_err(flags, 1, sigmoidf_(d) * siluf_(z), (float)MG[(size_t)r * 1024 + c - 2048]); }
        else if (c < 4096) {}
        else if (c < 4100) flag_err(flags, 3, d + bg[c - 4096], GT[(size_t)r * 8 + c - 4096]);
        else if (c < 4104) { const float gg = d + bg[c - 4096]; flag_err(flags, 3, fminf(gg, 0.f) - log1pf(expf(-fabsf(gg))), GT[(size_t)r * 8 + c - 4096]); }
        else if (c < 4616) flag_err(flags, 2, d * C2, (float)AQ[(size_t)r * 512 + c - 4104]);
        else if (c < 5128) flag_err(flags, 2, d, (float)AK[(size_t)r * 512 + c - 4616]);
        else if (c < 5640) flag_err(flags, 2, d, (float)AV[(size_t)r * 512 + c - 5128]);
        else if (c < 6152) flag_err(flags, 2, siluf_(d), (float)AZ[(size_t)r * 512 + c - 5640]);
        else if (c < 6664) flag_err(flags, 3, d * 0.125f, (float)IQ[(size_t)r * 512 + c - 6152]);
        else if (c < 6728) flag_err(flags, 3, d, (float)IK[(size_t)r * 64 + c - 6664]);
        else flag_err(flags, 3, d * 0.35355339059327373f, IW[(size_t)r * 8 + c - 6728]);
    }
}
__global__ void __launch_bounds__(512) k_check_out(Args a) {
    __shared__ float mx[1536]; __shared__ float pr[256]; __shared__ float h1row[1024]; __shared__ float erow[1024];
    const int tid = threadIdx.x; const int i = blockIdx.x; const int r = i * 128 + ((i * 37) & 127);
    unsigned* flags = (unsigned*)(a.ws + WS_FLAGS);
    const h16* MIX = (const h16*)((unsigned char*)a.out) + (size_t)r * DMIX; const float* p = a.in[1] + (size_t)r * DPLE;
    for (int k = tid; k < DMIX; k += 512) mx[k] = (float)MIX[k];
    if (tid < 256) pr[tid] = p[tid];
    __syncthreads();
    const float* Wo = a.in[5]; const float* Wp = a.in[9]; const float* x = a.in[0] + (size_t)r * DM;
    const float* H1 = (const float*)(a.ws + WS_H1) + (size_t)r * DM; const h16* H1H = (const h16*)(a.ws + WS_H1H) + (size_t)r * DM; const h16* PB = (const h16*)(a.ws + WS_PB) + (size_t)r * DM;
    for (int c = tid; c < DM; c += 512) {
        float d = x[c]; for (int k = 0; k < DMIX; ++k) d += mx[k] * Wo[(size_t)k * DM + c];
        flag_err(flags, 4, d, H1[c]); flag_err(flags, 4, d, (float)H1H[c]);
        float e = 0.f; for (int k = 0; k < DPLE; ++k) e += pr[k] * Wp[(size_t)k * DM + c];
        flag_err(flags, 5, e, (float)PB[c]);
        h1row[c] = d; erow[c] = e;
    }
    __syncthreads();
    const float* Wg = a.in[10]; float* DBG = (float*)(a.ws + WS_DBG) + (size_t)i * DM;
    for (int c = tid; c < DM; c += 512) { float gsum = 0.f; for (int k = 0; k < DM; ++k) gsum += h1row[k] * Wg[(size_t)k * DM + c];
        DBG[c] = h1row[c] + erow[c] * sigmoidf_(gsum); }
    if (tid < 64) { float s1 = 0.f, s2 = 0.f; for (int k = tid; k < 1024; k += 64) s1 += mx[k] * mx[k]; for (int k = 1024 + tid; k < 1536; k += 64) s2 += mx[k] * mx[k];
        s1 = wave_sum(s1) / 1024.f; s2 = wave_sum(s2) / 512.f;
        if (tid == 0) { if (!(s1 > 0.02f && s1 < 0.4f)) atomicMax(&flags[7], __float_as_uint(2.0f)); if (!(s2 > 0.0003f && s2 < 0.05f)) atomicMax(&flags[8], __float_as_uint(2.0f)); } }
}
__global__ void __launch_bounds__(512) k_check_h2(Args a) {
    const int tid = threadIdx.x; const int i = blockIdx.x; const int r = i * 128 + ((i * 37) & 127);
    unsigned* flags = (unsigned*)(a.ws + WS_FLAGS);
    const float* H2 = (const float*)(a.ws + WS_H1) + (size_t)r * DM; const float* DBG = (const float*)(a.ws + WS_DBG) + (size_t)i * DM;
    for (int c = tid; c < DM; c += 512) flag_err(flags, 6, DBG[c], H2[c]);
}

__global__ void __launch_bounds__(512) k_check_mlstm(Args a) {
    __shared__ float qt[128]; __shared__ float wgt[SEQ]; __shared__ float red[16]; __shared__ float F[SEQ];
    const int tid = threadIdx.x, lane = tid & 63, wave = tid >> 6;
    const int ti = blockIdx.x & 7;
    const int t = ti == 0 ? 65 : ti == 1 ? 500 : ti == 2 ? 1000 : ti == 3 ? 2047 : ti == 4 ? 2048 : ti == 5 ? 4100 : ti == 6 ? 6000 : 8191, b = (blockIdx.x >> 3) & 1, h = (blockIdx.x >> 3) ? 3 : 0;
    unsigned* flags = (unsigned*)(a.ws + WS_FLAGS);
    const h16* MQ = (const h16*)((unsigned char*)a.out + DO_MQ); const h16* MK = (const h16*)((unsigned char*)a.out + DO_MK); const h16* MV = (const h16*)((unsigned char*)a.out + DO_MV);
    const float* GT = (const float*)(a.ws + WS_GATES); const float* cw = a.in[4]; const float* HR = (const float*)(a.ws + WS_H1);
    if (tid < 128) { float y = 0.f; for (int j = 0; j < 4; ++j) { const int tt = t - 3 + j; if (tt >= 0) y += cw[j * 1024 + h * 128 + tid] * (float)MQ[(size_t)(b * SEQ + tt) * 512 + h * 128 + tid]; } qt[tid] = siluf_(y); }
    if (tid == 0) { float acc = 0.f; for (int s = 0; s <= t; ++s) { acc += GT[(size_t)(b * SEQ + s) * 8 + 4 + h]; F[s] = acc; } }
    __syncthreads();
    const float Ft = F[t];
    __syncthreads();
    float mx = -1e30f;
    for (int s = tid; s <= t; s += 512) { float qk = 0.f;
#pragma unroll 1
        for (int d = 0; d < 128; ++d) { float y = 0.f;
#pragma unroll
            for (int j = 0; j < 4; ++j) { const int tt = s - 3 + j; if (tt >= 0) y += cw[j * 1024 + 512 + h * 128 + d] * (float)MK[(size_t)(b * SEQ + tt) * 512 + h * 128 + d]; }
            qk += qt[d] * siluf_(y) * 0.08838834764831845f; }
        const float Dts = Ft - F[s] + GT[(size_t)(b * SEQ + s) * 8 + h]; mx = fmaxf(mx, Dts); wgt[s] = qk; F[s] = Dts; }
    __syncthreads();
#pragma unroll
    for (int o = 1; o < 64; o <<= 1) mx = fmaxf(mx, __shfl_xor(mx, o));
    if (lane == 0) red[wave] = mx; __syncthreads();
    float mt = Ft; for (int w = 0; w < 8; ++w) mt = fmaxf(mt, red[w]);
    float ds = 0.f;
    for (int s = tid; s <= t; s += 512) { const float wv = wgt[s] * expf(F[s] - mt); wgt[s] = wv; ds += wv; }
    ds = wave_sum(ds); if (lane == 0) red[8 + wave] = ds; __syncthreads();
    float den = 0.f; for (int w = 0; w < 8; ++w) den += red[8 + w];
    den = fmaxf(fabsf(den), expf(-mt));
    if (tid < 256) { float num = 0.f; for (int s = 0; s <= t; ++s) num += wgt[s] * (float)MV[(size_t)(b * SEQ + s) * 1024 + h * 256 + tid];
        flag_err(flags, 9, num / den, HR[(size_t)(b * SEQ + t) * 1024 + h * 256 + tid]); }
}
__global__ void __launch_bounds__(512) k_check_dsa(Args a) {
    __shared__ float sc[SEQ]; __shared__ float qf[512]; __shared__ int sel[256]; __shared__ int nsel; __shared__ float lg[8][256]; __shared__ float hm[8], hs[8];
    const int tid = threadIdx.x; const int ti = blockIdx.x & 7;
    const int t = ti == 0 ? 0 : ti == 1 ? 100 : ti == 2 ? 255 : ti == 3 ? 256 : ti == 4 ? 300 : ti == 5 ? 1000 : ti == 6 ? 5000 : 8191, b = blockIdx.x >> 3, row = b * SEQ + t;
    unsigned* flags = (unsigned*)(a.ws + WS_FLAGS);
    const h16* IQ = (const h16*)(a.ws + WS_IQ); const h16* IK = (const h16*)(a.ws + WS_IK); const float* IW = (const float*)(a.ws + WS_IW);
    const h16* AQ = (const h16*)(a.ws + WS_AQ); const h16* AK = (const h16*)(a.ws + WS_AK); const h16* AV = (const h16*)(a.ws + WS_AV); const h16* AZ = (const h16*)(a.ws + WS_AZ);
    const h16* MIX = (const h16*)((unsigned char*)a.out); const float* rb = a.in[8];
    qf[tid] = (float)IQ[(size_t)row * 512 + tid]; if (tid == 0) nsel = 0;
    __syncthreads();
    for (int s = tid; s <= t; s += 512) { float tot = 0.f;
#pragma unroll 1
        for (int hh = 0; hh < 8; ++hh) { float d = 0.f;
#pragma unroll 4
            for (int j = 0; j < 64; ++j) d += qf[hh * 64 + j] * (float)IK[(size_t)(b * SEQ + s) * 64 + j]; tot += IW[(size_t)row * 8 + hh] * fmaxf(d, 0.f); }
        sc[s] = tot; }
    __syncthreads();
    for (int s = tid; s <= t; s += 512) { const float v = sc[s]; int rank = 0; for (int s2 = 0; s2 <= t; ++s2) { const float v2 = sc[s2]; rank += (v2 > v || (v2 == v && s2 < s)) ? 1 : 0; }
        if (rank < 256) { const int p = atomicAdd(&nsel, 1); sel[p] = s; } }
    __syncthreads();
    const int ns = nsel;
    qf[tid] = (float)AQ[(size_t)row * 512 + tid];
    __syncthreads();
    for (int i = tid; i < 8 * ns; i += 512) { const int hh = i / ns, j = i % ns, s = sel[j]; float d = 0.f;
        for (int k = 0; k < 64; ++k) d += qf[hh * 64 + k] * (float)AK[(size_t)(b * SEQ + s) * 512 + hh * 64 + k];
        lg[hh][j] = d + rb[t5_bucket(t - s) * 8 + hh] * LOG2E; }
    __syncthreads();
    if (tid < 8) { float m = -1e30f; for (int j = 0; j < ns; ++j) m = fmaxf(m, lg[tid][j]); float ssum = 0.f; for (int j = 0; j < ns; ++j) ssum += exp2f(lg[tid][j] - m); hm[tid] = m; hs[tid] = ssum; }
    __syncthreads();
    { const int hh = tid >> 6, d = tid & 63; float o = 0.f; for (int j = 0; j < ns; ++j) o += exp2f(lg[hh][j] - hm[hh]) * (float)AV[(size_t)(b * SEQ + sel[j]) * 512 + hh * 64 + d];
      const float ref = o / hs[hh] * (float)AZ[(size_t)row * 512 + tid];
      const float got = (float)MIX[(size_t)row * DMIX + 1024 + tid];
      const float e = fabsf(ref - got) / (0.003f + 0.02f * fabsf(ref)); atomicMax(&flags[10], __float_as_uint(e == e ? e : 1e30f)); }
}

__global__ void __launch_bounds__(256) k_check_headnorm(Args a) {
    __shared__ float red[4];
    const int tid = threadIdx.x, lane = tid & 63, wave = tid >> 6, row = blockIdx.x >> 2, h = blockIdx.x & 3;
    unsigned* flags = (unsigned*)(a.ws + WS_FLAGS);
    const float* HR = (const float*)(a.ws + WS_H1) + (size_t)row * 1024 + h * 256; const h16* MG = (const h16*)(a.ws + WS_MG) + (size_t)row * 1024 + h * 256;
    const h16* MIX = (const h16*)((unsigned char*)a.out) + (size_t)row * DMIX + h * 256; const float* mn = a.in[7] + h * 256;
    const float v = HR[tid]; float s = wave_sum(v * v); if (lane == 0) red[wave] = s; __syncthreads();
    const float tot = red[0] + red[1] + red[2] + red[3];
    const float ref = v / sqrtf(tot / 256.f + EPS) * mn[tid] * (float)MG[tid];
    const float got = (float)MIX[tid]; const float e = fabsf(ref - got) / (0.003f + 0.01f * fabsf(ref)); atomicMax(&flags[11], __float_as_uint(e == e ? e : 1e30f));
    if (!(e <= 1.0f)) { atomicAdd(&flags[20], 1u); atomicMax(&flags[21], 65535u - (unsigned)blockIdx.x); atomicMax(&flags[22], (unsigned)blockIdx.x); }
}

#endif

extern "C" void kernel_launch(void* const* d_in, const int* in_sizes, int n_in, void* d_out, int out_size, void* d_ws, size_t ws_size, hipStream_t stream) {
    static int ok = 0;
    if (ok == 0) {
        if (n_in != 12 || in_sizes[0] != M * DM || out_size != M * DM || ws_size < WS_END) { fprintf(stderr, "kernel_launch: unexpected shapes (n_in %d, ws %zu)\n", n_in, ws_size); ok = -1; return; }
        if (hipFuncSetAttribute((const void*)fwd, hipFuncAttributeMaxDynamicSharedMemorySize, LDS_BYTES) != hipSuccess) { fprintf(stderr, "kernel_launch: hipFuncSetAttribute failed\n"); ok = -1; return; }
        ok = 1;
    }
    if (ok < 0) return;
    (void)hipMemsetAsync((char*)d_ws + WS_CTL, 0, CTL_ZERO_BYTES, stream);
    Args a{};
    for (int i = 0; i < 12; ++i) a.in[i] = (const float*)d_in[i];
    a.out = (float*)d_out; a.ws = (unsigned char*)d_ws;
#if DEBUG_CHECKS
    for (int ph = 0; ph < NPH; ++ph) { a.ph_lo = ph; a.ph_hi = ph + 1; hipLaunchKernelGGL(fwd, dim3(256), dim3(512), LDS_BYTES, stream, a);
        if (ph == 1) hipLaunchKernelGGL(k_check_proj, dim3(M), dim3(512), 0, stream, a);
        if (ph == 2) hipLaunchKernelGGL(k_check_mlstm, dim3(16), dim3(512), 0, stream, a);
        if (ph == 3) { hipLaunchKernelGGL(k_check_headnorm, dim3(M * 4), dim3(256), 0, stream, a); hipLaunchKernelGGL(k_check_dsa, dim3(16), dim3(512), 0, stream, a); }
        if (ph == 4) hipLaunchKernelGGL(k_check_out, dim3(128), dim3(512), 0, stream, a); }
#else
    a.ph_lo = 0; a.ph_hi = NPH;
    hipLaunchKernelGGL(fwd, dim3(256), dim3(512), LDS_BYTES, stream, a);
#endif
}
```

```cpp
#include <hip/hip_runtime.h>
#include <cstdio>
#include <cstdint>
#ifndef DEBUG_CHECKS
#define DEBUG_CHECKS 0
#endif

constexpr int BATCH = 2, SEQ = 8192, DM = 1024, M = BATCH * SEQ;
constexpr int NPROJ = 6736, NPAD = 6912;
constexpr int DMIX = 1536, DPLE = 256;
constexpr float EPS = 1e-6f;
constexpr float LOG2E = 1.4426950408889634f;
constexpr float C2 = 0.125f * LOG2E;

constexpr size_t MiB = 1u << 20;
constexpr size_t WS_CTL = 0, CTL_ZERO_BYTES = 1 * MiB;
constexpr size_t WS_WIN = 1 * MiB;
constexpr size_t WS_WOUT = 15 * MiB;
constexpr size_t WS_WGATE = 18 * MiB;
constexpr size_t WS_WPLE = 20 * MiB;
constexpr size_t WS_BT = 20 * MiB + 512 * 1024;
constexpr size_t WS_IK = 21 * MiB;
constexpr size_t WS_IW = 23 * MiB;
constexpr size_t WS_GATES = 23 * MiB + 512 * 1024;
constexpr size_t WS_P16 = 24 * MiB;
constexpr size_t WS_XN = 32 * MiB;
constexpr size_t WS_MASKB = 32 * MiB;
constexpr size_t WS_IQ = 64 * MiB;
constexpr size_t WS_MIX = 32 * MiB;
constexpr size_t WS_AQ = 80 * MiB, WS_AK = 96 * MiB, WS_AV = 112 * MiB, WS_AZ = 128 * MiB;
constexpr size_t WS_H1H = 80 * MiB;
constexpr size_t WS_PB = 112 * MiB;
constexpr size_t WS_MG = 144 * MiB;
constexpr size_t WS_MASK = 176 * MiB;
constexpr size_t WS_H1 = 192 * MiB;
constexpr size_t WS_END = 256 * MiB;
constexpr size_t WS_DBG = 14 * MiB + 512 * 1024;
constexpr size_t WS_FLAGS = 512 * 1024;
constexpr size_t DO_MQ = 0, DO_MK = 16 * MiB, DO_MV = 32 * MiB;
constexpr size_t DO_MIX = 0;

typedef _Float16 h16;
typedef _Float16 h16x2 __attribute__((ext_vector_type(2)));
typedef _Float16 h16x4 __attribute__((ext_vector_type(4)));
typedef _Float16 h16x8 __attribute__((ext_vector_type(8)));
typedef short s16x8 __attribute__((ext_vector_type(8)));
typedef float f32x4 __attribute__((ext_vector_type(4)));
typedef float f32x2 __attribute__((ext_vector_type(2)));
typedef unsigned u32x4 __attribute__((ext_vector_type(4)));
typedef unsigned u32x2 __attribute__((ext_vector_type(2)));
#define LAS __attribute__((address_space(3)))
#define GAS __attribute__((address_space(1)))

__device__ __forceinline__ unsigned pkh(float lo, float hi) { h16x2 v = {(h16)lo, (h16)hi}; return __builtin_bit_cast(unsigned, v); }
__device__ __forceinline__ float sigmoidf_(float x) { return 1.0f / (1.0f + __expf(-x)); }
__device__ __forceinline__ float siluf_(float x) { return x / (1.0f + __expf(-x)); }
__device__ __forceinline__ float h2f(unsigned short b) { return (float)__builtin_bit_cast(h16, b); }

struct Args { const float* in[12]; float* out; unsigned char* ws; int ph_lo, ph_hi; };

namespace pg8 {
constexpr int BM = 256, BK = 64, HALF = 128, HTB = HALF * BK * 2, STAGE_BYTES = 8 * HTB, NXCD = 8, WGM = 8;
__host__ __device__ __forceinline__ int lds_byte(int r, int c) { const int st = (r >> 4) * 2 + (c >> 5), rr = r & 15, cc = c & 31, ob = rr * 64 + cc * 2; return st * 1024 + (ob ^ (((ob >> 9) & 1) << 5)); }
__host__ __device__ __forceinline__ void stage_rc(int b, int& R, int& C) { const int st = b / 1024, sb = b % 1024, swz = sb ^ (((sb >> 9) & 1) << 5); R = (st >> 1) * 16 + swz / 64; C = (st & 1) * 32 + (swz % 64) / 2; }
__host__ __device__ __forceinline__ int perm32(int rho) { const int n = rho >> 4, i = rho & 15; return 8 * (i >> 2) + 4 * n + (i & 3); }

struct Unit { int pm, pn; };
struct Gemm { const h16* A; const h16* Bt; int M, N, K; };

struct StaticOrder {
    int nM, nN, nwg, G, c;
    __host__ __device__ void init(int M_, int N_, int G_, int c_) { nM = M_ / BM; nN = N_ / BM; nwg = nM * nN; G = G_; c = c_; }
    __host__ __device__ bool next(int i, Unit& u) const {
        const long L = (long)i * G + c; if (L >= nwg) return false;
        int wgid = (int)L; { const int q = nwg / NXCD, r = nwg % NXCD, xcd = wgid % NXCD, off = wgid / NXCD; wgid = (xcd < r ? xcd * (q + 1) : r * (q + 1) + (xcd - r) * q) + off; }
        const int nig = WGM * nN, gid = wgid / nig, fm = gid * WGM, gsz = (nM - fm) < WGM ? (nM - fm) : WGM;
        u.pm = fm + ((wgid % nig) % gsz); u.pn = (wgid % nig) / gsz; return true;
    }
};

template <class Epi, class Sched, bool ALIGN_EPI = false, bool SP2 = false>
__device__ __forceinline__ void gemm_phase(LAS unsigned char* lds, const Gemm g, const Sched& S, const Epi& E) {
    const int tid = threadIdx.x, wid = __builtin_amdgcn_readfirstlane(tid >> 6), lane = tid & 63, wr = wid >> 2, wc = wid & 3, fr = lane & 15, fq = lane >> 4;
    const int K = g.K, nt = K / BK;
    unsigned voffA[2], voffB[2];
#pragma unroll
    for (int i = 0; i < 2; ++i) { int R, C; stage_rc(tid * 16 + i * 8192, R, C); const int Rb = Epi::PERM ? ((R & ~31) + perm32(R & 31)) : R;
        voffA[i] = (unsigned)(R * K + C) * 2u; voffB[i] = (unsigned)(Rb * K + C) * 2u; }
    const size_t kstep = (size_t)(BK * 2);
    const size_t hstep = (size_t)HALF * K * 2;
    const size_t tstep = 2 * hstep;
    const unsigned ldsw = (unsigned)wid * 1024u;
    const int aoff = lds_byte(wr * 64 + fr, fq * 8), boff = lds_byte(wc * 32 + fr, fq * 8);
#define PG8_SA(b, h) (((b) * 2 + (h)) * HTB)
#define PG8_SB(b, h) ((4 + (b) * 2 + (h)) * HTB)
#define PG8_STAGE(bufoff, gbase, voff) do { _Pragma("unroll") for (int _i = 0; _i < 2; ++_i) \
        __builtin_amdgcn_global_load_lds((const unsigned*)((const char*)(gbase) + (voff)[_i]), (LAS unsigned*)(lds + (bufoff) + ldsw + _i * 8192), 16, 0, 0); } while (0)
#define PG8_LDA(dst, b, h) do { _Pragma("unroll") for (int m = 0; m < 4; ++m) _Pragma("unroll") for (int k = 0; k < 2; ++k) dst[m][k] = *(const LAS h16x8*)(lds + PG8_SA(b, h) + aoff + m * 2048 + k * 1024); } while (0)
#define PG8_LDB(dst, b, h) do { _Pragma("unroll") for (int n = 0; n < 2; ++n) _Pragma("unroll") for (int k = 0; k < 2; ++k) dst[n][k] = *(const LAS h16x8*)(lds + PG8_SB(b, h) + boff + n * 2048 + k * 1024); } while (0)
#define PG8_MMA(ai, bj, At, Bt) do { __builtin_amdgcn_s_setprio(1); _Pragma("unroll") for (int m = 0; m < 4; ++m) _Pragma("unroll") for (int n = 0; n < 2; ++n) _Pragma("unroll") for (int k = 0; k < 2; ++k) \
        acc[ai][bj][m][n] = __builtin_amdgcn_mfma_f32_16x16x32_f16(Bt[n][k], At[m][k], acc[ai][bj][m][n], 0, 0, 0); __builtin_amdgcn_s_setprio(0); } while (0)
#define PG8_WAIT_V(n) asm volatile("s_waitcnt vmcnt(" #n ")" ::: "memory")
#define PG8_WAIT_L(n) asm volatile("s_waitcnt lgkmcnt(" #n ")" ::: "memory")
#define PG8_BAR __builtin_amdgcn_s_barrier()
#define PG8_SCHED __builtin_amdgcn_sched_barrier(0)
    Unit cur, nxt; int ui = 0;
    if (!S.next(0, cur)) return;
    f32x4 acc[2][2][4][2];
#pragma unroll
    for (int a = 0; a < 2; ++a)
#pragma unroll
        for (int b = 0; b < 2; ++b)
#pragma unroll
            for (int m = 0; m < 4; ++m)
#pragma unroll
                for (int n = 0; n < 2; ++n) acc[a][b][m][n] = (f32x4){0.f, 0.f, 0.f, 0.f};
    h16x8 At[4][2], B0[2][2], B1[2][2];
    const char* cA = (const char*)g.A + (size_t)cur.pm * tstep; const char* cB = (const char*)g.Bt + (size_t)cur.pn * tstep;
    if constexpr (SP2) {
        PG8_STAGE(PG8_SB(0, 0), cB, voffB); PG8_STAGE(PG8_SB(0, 1), cB + hstep, voffB); PG8_STAGE(PG8_SA(0, 0), cA, voffA); PG8_STAGE(PG8_SA(0, 1), cA + hstep, voffA);
        if (wr == 1) PG8_BAR;
        PG8_WAIT_V(2); PG8_BAR;
        PG8_STAGE(PG8_SB(1, 0), cB + kstep, voffB); PG8_STAGE(PG8_SA(1, 0), cA + kstep, voffA); PG8_STAGE(PG8_SB(1, 1), cB + hstep + kstep, voffB);
        PG8_WAIT_V(6); PG8_BAR;
    } else {
        PG8_STAGE(PG8_SB(0, 0), cB, voffB); PG8_STAGE(PG8_SA(0, 0), cA, voffA); PG8_STAGE(PG8_SB(0, 1), cB + hstep, voffB); PG8_STAGE(PG8_SA(0, 1), cA + hstep, voffA);
        if (wr == 1) PG8_BAR;
        PG8_WAIT_V(4); PG8_BAR;
        PG8_STAGE(PG8_SB(1, 0), cB + kstep, voffB); PG8_STAGE(PG8_SA(1, 0), cA + kstep, voffA); PG8_STAGE(PG8_SB(1, 1), cB + hstep + kstep, voffB);
        PG8_WAIT_V(6); PG8_BAR;
    }
    for (;;) {
        const bool has_next = S.next(ui + 1, nxt);
        const char* nA = has_next ? (const char*)g.A + (size_t)nxt.pm * tstep : cA; const char* nB = has_next ? (const char*)g.Bt + (size_t)nxt.pn * tstep : cB;
        for (int t = 0; t < nt; t += 2) {
            const bool last = (t == nt - 2);
            const char* a1 = cA + (size_t)(t + 1) * kstep;
            const char* a2 = last ? nA : cA + (size_t)(t + 2) * kstep; const char* b2 = last ? nB : cB + (size_t)(t + 2) * kstep;
            const char* a3 = a2 + kstep; const char* b3 = b2 + kstep;
            if constexpr (SP2) {
            PG8_LDB(B0, 0, 0); PG8_LDB(B1, 0, 1); PG8_SCHED; PG8_LDA(At, 0, 0); PG8_STAGE(PG8_SA(1, 1), a1 + hstep, voffA);
            PG8_WAIT_V(8); PG8_WAIT_L(0); PG8_BAR; PG8_MMA(0, 0, At, B0); PG8_MMA(0, 1, At, B1); PG8_BAR; PG8_SCHED;
            PG8_LDA(At, 0, 1); PG8_STAGE(PG8_SB(0, 0), b2, voffB); PG8_STAGE(PG8_SB(0, 1), b2 + hstep, voffB); PG8_STAGE(PG8_SA(0, 0), a2, voffA);
            PG8_WAIT_V(8); PG8_WAIT_L(0); PG8_BAR; PG8_MMA(1, 0, At, B0); PG8_MMA(1, 1, At, B1); PG8_BAR; PG8_SCHED;
            PG8_LDB(B0, 1, 0); PG8_LDB(B1, 1, 1); PG8_SCHED; PG8_LDA(At, 1, 0); PG8_STAGE(PG8_SA(0, 1), a2 + hstep, voffA);
            PG8_WAIT_V(8); PG8_WAIT_L(0); PG8_BAR; PG8_MMA(0, 0, At, B0); PG8_MMA(0, 1, At, B1); PG8_BAR; PG8_SCHED;
            PG8_LDA(At, 1, 1); PG8_STAGE(PG8_SB(1, 0), b3, voffB); PG8_STAGE(PG8_SB(1, 1), b3 + hstep, voffB); PG8_STAGE(PG8_SA(1, 0), a3, voffA);
            PG8_WAIT_V(8); PG8_WAIT_L(0); PG8_BAR; PG8_MMA(1, 0, At, B0); PG8_MMA(1, 1, At, B1); PG8_BAR; PG8_SCHED;
            } else {
            PG8_LDB(B0, 0, 0); PG8_SCHED; PG8_LDA(At, 0, 0); PG8_STAGE(PG8_SA(1, 1), a1 + hstep, voffA);
            PG8_WAIT_L(8); PG8_BAR; PG8_WAIT_L(0); PG8_MMA(0, 0, At, B0); PG8_BAR; PG8_SCHED;
            PG8_LDB(B1, 0, 1); PG8_STAGE(PG8_SB(0, 0), b2, voffB);
            PG8_BAR; PG8_WAIT_L(0); PG8_MMA(0, 1, At, B1); PG8_BAR;
            PG8_LDA(At, 0, 1); PG8_STAGE(PG8_SA(0, 0), a2, voffA);
            PG8_BAR; PG8_WAIT_L(0); PG8_MMA(1, 0, At, B0); PG8_BAR; PG8_SCHED;
            PG8_STAGE(PG8_SB(0, 1), b2 + hstep, voffB);
            PG8_WAIT_V(6); PG8_BAR; PG8_MMA(1, 1, At, B1); PG8_BAR;
            PG8_LDB(B0, 1, 0); PG8_SCHED; PG8_LDA(At, 1, 0); PG8_STAGE(PG8_SA(0, 1), a2 + hstep, voffA);
            PG8_WAIT_L(8); PG8_BAR; PG8_WAIT_L(0); PG8_MMA(0, 0, At, B0); PG8_BAR; PG8_SCHED;
            PG8_LDB(B1, 1, 1); PG8_STAGE(PG8_SB(1, 0), b3, voffB);
            PG8_BAR; PG8_WAIT_L(0); PG8_MMA(0, 1, At, B1); PG8_BAR;
            PG8_LDA(At, 1, 1); PG8_STAGE(PG8_SA(1, 0), a3, voffA);
            PG8_BAR; PG8_WAIT_L(0); PG8_MMA(1, 0, At, B0); PG8_BAR; PG8_SCHED;
            PG8_STAGE(PG8_SB(1, 1), b3 + hstep, voffB);
            PG8_WAIT_V(6); PG8_BAR; PG8_MMA(1, 1, At, B1); PG8_BAR;
            }
        }
        if constexpr (ALIGN_EPI) { if (wr == 0) PG8_BAR; }
        E(acc, cur, wr, wc, fr, fq);
        if (!has_next) break;
#pragma unroll
        for (int a = 0; a < 2; ++a)
#pragma unroll
            for (int b = 0; b < 2; ++b)
#pragma unroll
                for (int m = 0; m < 4; ++m)
#pragma unroll
                    for (int n = 0; n < 2; ++n) acc[a][b][m][n] = (f32x4){0.f, 0.f, 0.f, 0.f};
        cur = nxt; cA = nA; cB = nB; ++ui;
        if constexpr (ALIGN_EPI) { if (wr == 1) PG8_BAR; }
    }
    PG8_WAIT_V(0);
    if constexpr (!ALIGN_EPI) { if (wr == 0) PG8_BAR; }
    PG8_BAR;
#undef PG8_SA
#undef PG8_SB
#undef PG8_STAGE
#undef PG8_LDA
#undef PG8_LDB
#undef PG8_MMA
#undef PG8_WAIT_V
#undef PG8_WAIT_L
#undef PG8_BAR
#undef PG8_SCHED
}

struct EpiProj {
    static constexpr bool PERM = true;
    unsigned char* ws; unsigned char* dout; const float* b_gate;
    __device__ __forceinline__ void operator()(const f32x4 (&acc)[2][2][4][2], const Unit& u, int wr, int wc, int fr, int fq) const {
        const int pn = u.pn; const int row0 = u.pm * BM + wr * 64 + fr; const int cw = wc * 32 + 8 * fq;
        if (pn >= 8 && pn < 16) {
            h16* base = (h16*)(ws + WS_MG) + (pn - 8) * 128 + cw;
#pragma unroll
            for (int ai = 0; ai < 2; ++ai)
#pragma unroll
                for (int m = 0; m < 4; ++m) { const f32x4 o0 = acc[ai][0][m][0], o1 = acc[ai][0][m][1], z0 = acc[ai][1][m][0], z1 = acc[ai][1][m][1];
                    float r[8];
#pragma unroll
                    for (int j = 0; j < 4; ++j) { r[j] = sigmoidf_(o0[j]) * siluf_(z0[j]); r[4 + j] = sigmoidf_(o1[j]) * siluf_(z1[j]); }
                    u32x4 w; w.x = pkh(r[0], r[1]); w.y = pkh(r[2], r[3]); w.z = pkh(r[4], r[5]); w.w = pkh(r[6], r[7]);
                    *(u32x4*)(base + (size_t)(row0 + ai * HALF + m * 16) * 1024) = w; }
            return;
        }
        if (pn == 26) {
            if (wc < 2) { h16* base = (h16*)(ws + WS_IK) + cw;
#pragma unroll
                for (int ai = 0; ai < 2; ++ai)
#pragma unroll
                    for (int m = 0; m < 4; ++m) { const f32x4 v0 = acc[ai][0][m][0], v1 = acc[ai][0][m][1];
                        u32x4 w; w.x = pkh(v0[0], v0[1]); w.y = pkh(v0[2], v0[3]); w.z = pkh(v1[0], v1[1]); w.w = pkh(v1[2], v1[3]);
                        *(u32x4*)(base + (size_t)(row0 + ai * HALF + m * 16) * 64) = w; }
            } else if (wc == 2 && fq == 0) { float* base = (float*)(ws + WS_IW); const float sc = 0.35355339059327373f;
#pragma unroll
                for (int ai = 0; ai < 2; ++ai)
#pragma unroll
                    for (int m = 0; m < 4; ++m) { float* p = base + (size_t)(row0 + ai * HALF + m * 16) * 8; *(f32x4*)p = acc[ai][0][m][0] * sc; *(f32x4*)(p + 4) = acc[ai][0][m][1] * sc; }
            } else if (wc == 2 && fq == 1) { float* base = (float*)(ws + WS_GATES); const f32x4 bi = *(const f32x4*)b_gate, bf = *(const f32x4*)(b_gate + 4);
#pragma unroll
                for (int ai = 0; ai < 2; ++ai)
#pragma unroll
                    for (int m = 0; m < 4; ++m) { float* p = base + (size_t)(row0 + ai * HALF + m * 16) * 8; *(f32x4*)p = acc[ai][0][m][0] + bi;
                        const f32x4 g = acc[ai][0][m][1] + bf; f32x4 lf;
#pragma unroll
                        for (int j = 0; j < 4; ++j) lf[j] = fminf(g[j], 0.f) - log1pf(expf(-fabsf(g[j])));
                        *(f32x4*)(p + 4) = lf; }
            }
            return;
        }
        h16* base; int pitch; int coff; float sc = 1.f; bool act = false;
        if (pn < 2)       { base = (h16*)(dout + DO_MQ); pitch = 512;  coff = pn * 256; }
        else if (pn < 4)  { base = (h16*)(dout + DO_MK); pitch = 512;  coff = (pn - 2) * 256; }
        else if (pn < 8)  { base = (h16*)(dout + DO_MV); pitch = 1024; coff = (pn - 4) * 256; }
        else if (pn < 18) { base = (h16*)(ws + WS_AQ);   pitch = 512;  coff = (pn - 16) * 256; sc = C2; }
        else if (pn < 20) { base = (h16*)(ws + WS_AK);   pitch = 512;  coff = (pn - 18) * 256; }
        else if (pn < 22) { base = (h16*)(ws + WS_AV);   pitch = 512;  coff = (pn - 20) * 256; }
        else if (pn < 24) { base = (h16*)(ws + WS_AZ);   pitch = 512;  coff = (pn - 22) * 256; act = true; }
        else              { base = (h16*)(ws + WS_IQ);   pitch = 512;  coff = (pn - 24) * 256; sc = 0.125f; }
#pragma unroll
        for (int ai = 0; ai < 2; ++ai)
#pragma unroll
            for (int m = 0; m < 4; ++m) { h16* rowp = base + (size_t)(row0 + ai * HALF + m * 16) * pitch + coff + cw;
#pragma unroll
                for (int bj = 0; bj < 2; ++bj) { f32x4 v0 = acc[ai][bj][m][0], v1 = acc[ai][bj][m][1];
                    if (act) {
#pragma unroll
                        for (int j = 0; j < 4; ++j) { v0[j] = siluf_(v0[j]); v1[j] = siluf_(v1[j]); } }
                    v0 = v0 * sc; v1 = v1 * sc;
                    u32x4 w; w.x = pkh(v0[0], v0[1]); w.y = pkh(v0[2], v0[3]); w.z = pkh(v1[0], v1[1]); w.w = pkh(v1[2], v1[3]);
                    *(u32x4*)(rowp + bj * HALF) = w; } }
    }
};
struct EpiF16 {
    static constexpr bool PERM = true;
    h16* O; int ldc;
    __device__ __forceinline__ void operator()(const f32x4 (&acc)[2][2][4][2], const Unit& u, int wr, int wc, int fr, int fq) const {
        const int row0 = u.pm * BM + wr * 64 + fr; const int col0 = u.pn * BM + wc * 32 + 8 * fq;
#pragma unroll
        for (int ai = 0; ai < 2; ++ai)
#pragma unroll
            for (int m = 0; m < 4; ++m) { h16* rowp = O + (size_t)(row0 + ai * HALF + m * 16) * ldc + col0;
#pragma unroll
                for (int bj = 0; bj < 2; ++bj) { const f32x4 v0 = acc[ai][bj][m][0], v1 = acc[ai][bj][m][1];
                    u32x4 w; w.x = pkh(v0[0], v0[1]); w.y = pkh(v0[2], v0[3]); w.z = pkh(v1[0], v1[1]); w.w = pkh(v1[2], v1[3]);
                    *(u32x4*)(rowp + bj * HALF) = w; } }
    }
};
struct EpiOut {
    static constexpr bool PERM = false;
    const float* x; float* h1; h16* h1h;
    __device__ __forceinline__ void operator()(const f32x4 (&acc)[2][2][4][2], const Unit& u, int wr, int wc, int fr, int fq) const {
        const int row0 = u.pm * BM + wr * 64 + fr; const int col0 = u.pn * BM + wc * 32 + 4 * fq;
#pragma unroll
        for (int ai = 0; ai < 2; ++ai)
#pragma unroll
            for (int m = 0; m < 4; ++m) { const size_t off = (size_t)(row0 + ai * HALF + m * 16) * DM + col0;
#pragma unroll
                for (int bj = 0; bj < 2; ++bj)
#pragma unroll
                    for (int n = 0; n < 2; ++n) { const size_t o = off + bj * HALF + n * 16; const f32x4 v = *(const f32x4*)(x + o) + acc[ai][bj][m][n];
                        *(f32x4*)(h1 + o) = v; u32x2 w; w.x = pkh(v[0], v[1]); w.y = pkh(v[2], v[3]); *(u32x2*)(h1h + o) = w; } }
    }
};
struct EpiF32 {
    static constexpr bool PERM = false;
    float* O; int ldc;
    __device__ __forceinline__ void operator()(const f32x4 (&acc)[2][2][4][2], const Unit& u, int wr, int wc, int fr, int fq) const {
        const int row0 = u.pm * BM + wr * 64 + fr; const int col0 = u.pn * BM + wc * 32 + 4 * fq;
#pragma unroll
        for (int ai = 0; ai < 2; ++ai)
#pragma unroll
            for (int m = 0; m < 4; ++m) { const size_t off = (size_t)(row0 + ai * HALF + m * 16) * ldc + col0;
#pragma unroll
                for (int bj = 0; bj < 2; ++bj)
#pragma unroll
                    for (int n = 0; n < 2; ++n) *(f32x4*)(O + off + bj * HALF + n * 16) = acc[ai][bj][m][n]; }
    }
};
}

__device__ __forceinline__ float wave_sum(float v) {
#pragma unroll
    for (int o = 1; o < 64; o <<= 1) v += __shfl_xor(v, o);
    return v;
}
__device__ __forceinline__ int win_map(int n) {
    if (n < 2048) return n;
    if (n < 3072) { const int j = n - 2048; return 2048 + (j >> 7) * 256 + (j & 127); }
    if (n < 4096) { const int j = n - 3072; return 2048 + (j >> 7) * 256 + 128 + (j & 127); }
    if (n < 4104) return 6728 + (n - 4096);
    if (n < 6664) return 4096 + (n - 4104);
    if (n < 6728) return 6656 + (n - 6664);
    return 6720 + (n - 6728);
}
template <bool MAP>
__device__ __forceinline__ void p0_transpose_item(const float* W, int K, int N, h16* WT, LAS float* scr, int item, int lane) {
    const int nblk = (N + 31) / 32, kb = item / nblk, nb = item % nblk, k0 = 64 * kb, n0 = 32 * nb;
    const int ncol = n0 + (lane & 31);
#pragma unroll 8
    for (int i = 0; i < 32; ++i) { const int kk = 2 * i + (lane >> 5); scr[kk * 33 + (lane & 31)] = (ncol < N) ? W[(size_t)(k0 + kk) * N + ncol] : 0.f; }
    asm volatile("s_waitcnt lgkmcnt(0)" ::: "memory");
    const int c = lane & 7;
#pragma unroll
    for (int j = 0; j < 4; ++j) { const int n = (lane >> 3) + 8 * j; const LAS float* s = scr + (8 * c) * 33 + n;
        u32x4 o; o.x = pkh(s[0 * 33], s[1 * 33]); o.y = pkh(s[2 * 33], s[3 * 33]); o.z = pkh(s[4 * 33], s[5 * 33]); o.w = pkh(s[6 * 33], s[7 * 33]);
        if (n0 + n < N) { const int row = MAP ? win_map(n0 + n) : (n0 + n); *(u32x4*)(WT + (size_t)row * K + k0 + 8 * c) = o; } }
    asm volatile("s_waitcnt lgkmcnt(0)" ::: "memory");
}
__device__ __forceinline__ int t5_bucket(int dist) {
    if (dist < 16) return dist;
    const int large = 16 + (int)(logf((float)dist * (1.0f / 16.0f)) / logf(8.0f) * 16.0f);
    return large < 31 ? large : 31;
}

#define XB_TMO      128
#define XB_XCNT(j)  (256  + 64 * (j))
#define XB_XSUB(j)  (1280 + 64 * (j))
#define XB_XGEN(j)  (2304 + 64 * (j))
#define XB_TOP      3328
#define XB_TOPGEN   3392
#define XCD_BAR_WORDS 3456
#define XB_SPIN_CAP (1u << 18)
__device__ __forceinline__ unsigned xb_ld(unsigned* p)              { return __hip_atomic_load(p, __ATOMIC_RELAXED, __HIP_MEMORY_SCOPE_AGENT); }
__device__ __forceinline__ unsigned xb_add(unsigned* p, unsigned v) { return __hip_atomic_fetch_add(p, v, __ATOMIC_RELAXED, __HIP_MEMORY_SCOPE_AGENT); }
__device__ __forceinline__ unsigned xb_xcc_id() { return (unsigned)__builtin_amdgcn_s_getreg((3 << 11) | 20) & 0xFu; }
#define XB_SPIN(cond, bar) do { unsigned _sp = 0; while (cond) { __builtin_amdgcn_s_sleep(1); \
    if ((++_sp & 255u) == 0u) { if (xb_ld(&(bar)[XB_TMO])) break; if (_sp > XB_SPIN_CAP) { atomicAdd(&(bar)[XB_TMO], 1u); break; } } } } while (0)
struct XcdBarrier { unsigned* bar; unsigned x; volatile LAS unsigned* st; };
__device__ __forceinline__ XcdBarrier xcd_barrier_post(unsigned* bar, volatile LAS unsigned* st) {
    XcdBarrier b; b.bar = bar; b.x = xb_xcc_id(); b.st = st;
    if (threadIdx.x == 0) (void)xb_add(&bar[XB_XCNT(b.x)], 1u);
    return b;
}
__device__ __forceinline__ void xcd_barrier_complete(unsigned* bar, unsigned x, unsigned& nloc, unsigned& nx) {
    const unsigned G = gridDim.x * gridDim.y * gridDim.z;
    unsigned sum, cnt, mine, sp = 0u;
    for (;;) {
        sum = 0u; cnt = 0u; mine = 0u;
#pragma unroll
        for (unsigned j = 0; j < 16; ++j) { const unsigned c = xb_ld(&bar[XB_XCNT(j)]); sum += c; cnt += (c > 0u) ? 1u : 0u; mine = (j == x) ? c : mine; }
        if (sum == G) break;
        __builtin_amdgcn_s_sleep(1);
        if ((++sp & 255u) == 0u) { if (xb_ld(&bar[XB_TMO])) break; if (sp > XB_SPIN_CAP) { atomicAdd(&bar[XB_TMO], 1u); break; } }
    }
    nloc = mine > 0u ? mine : 1u; nx = cnt > 0u ? cnt : 1u;
}
__device__ __forceinline__ void xcd_barrier(const XcdBarrier& b) {
    asm volatile("s_waitcnt vmcnt(0)" ::: "memory");
    __syncthreads();
    if (threadIdx.x == 0) {
        unsigned* bar = b.bar;
        __builtin_amdgcn_s_waitcnt(0);
        unsigned nloc = b.st[0], nx = b.st[1];
        if (nloc == 0u) { xcd_barrier_complete(bar, b.x, nloc, nx); b.st[0] = nloc; b.st[1] = nx; }
        const unsigned old = xb_add(&bar[XB_XSUB(b.x)], 1u);
        const unsigned gen = old / nloc;
        if (old + 1u == (gen + 1u) * nloc) {
            __builtin_amdgcn_fence(__ATOMIC_RELEASE, "agent");
            asm volatile("s_waitcnt vmcnt(0)" ::: "memory");
            const unsigned og = xb_add(&bar[XB_TOP], 1u);
            const unsigned tg = og / nx;
            if (og + 1u == (tg + 1u) * nx) xb_add(&bar[XB_TOPGEN], 1u);
            else XB_SPIN(xb_ld(&bar[XB_TOPGEN]) == tg, bar);
            __builtin_amdgcn_fence(__ATOMIC_ACQUIRE, "agent");
            xb_add(&bar[XB_XGEN(b.x)], 1u);
            asm volatile("s_waitcnt vmcnt(0)" ::: "memory");
        } else {
            XB_SPIN(xb_ld(&bar[XB_XGEN(b.x)]) == gen, bar);
            __builtin_amdgcn_fence(__ATOMIC_ACQUIRE, "agent");
            asm volatile("s_waitcnt vmcnt(0)" ::: "memory");
        }
    }
    __syncthreads();
}

constexpr int RING_BYTES = 131072, LDSCTL_OFF = RING_BYTES, LDS_BYTES = 147456;
constexpr int CW_BAR = 4096;

__device__ __forceinline__ void phase_prologue(const Args& a, LAS unsigned char* lds) {
    const int tid = threadIdx.x, lane = tid & 63, wave = tid >> 6;
    LAS float* scr = (LAS float*)(lds + wave * 16384);
    const int gw = blockIdx.x * 8 + wave, NGW = gridDim.x * 8;
    const float* w_in = a.in[2]; const float* w_out = a.in[5]; const float* w_ple = a.in[9]; const float* w_gate = a.in[10];
    h16* WIN = (h16*)(a.ws + WS_WIN); h16* WOUT = (h16*)(a.ws + WS_WOUT); h16* WGATE = (h16*)(a.ws + WS_WGATE); h16* WPLE = (h16*)(a.ws + WS_WPLE);
    constexpr int I_IN = (DM / 64) * ((NPROJ + 31) / 32), I_OUT = (DMIX / 64) * (DM / 32), I_G = (DM / 64) * (DM / 32), I_P = (DPLE / 64) * (DM / 32);
    constexpr int NITEMS = I_IN + I_OUT + I_G + I_P;
    for (int it = gw; it < NITEMS; it += NGW) {
        int r = it;
        if (r < I_IN) { p0_transpose_item<true>(w_in, DM, NPROJ, WIN, scr, r, lane); continue; } r -= I_IN;
        if (r < I_OUT) { p0_transpose_item<false>(w_out, DMIX, DM, WOUT, scr, r, lane); continue; } r -= I_OUT;
        if (r < I_G) { p0_transpose_item<false>(w_gate, DM, DM, WGATE, scr, r, lane); continue; } r -= I_G;
        p0_transpose_item<false>(w_ple, DPLE, DM, WPLE, scr, r, lane);
    }
    for (int r = gw; r < NPAD - NPROJ; r += NGW) { u32x4* p = (u32x4*)(WIN + (size_t)(NPROJ + r) * DM) + lane; p[0] = (u32x4){0, 0, 0, 0}; p[64] = (u32x4){0, 0, 0, 0}; }
    const float* x = a.in[0]; const float* p = a.in[1]; const float* g_in = a.in[6];
    h16* XN = (h16*)(a.ws + WS_XN); h16* P16 = (h16*)(a.ws + WS_P16);
    f32x4 gv[4];
#pragma unroll
    for (int j = 0; j < 4; ++j) gv[j] = ((const f32x4*)g_in)[lane + 64 * j];
    for (int m = gw; m < M; m += NGW) {
        const f32x4* xr = (const f32x4*)(x + (size_t)m * DM) + lane; f32x4 v[4]; float s = 0.f;
#pragma unroll
        for (int j = 0; j < 4; ++j) { v[j] = xr[64 * j]; s += (v[j].x * v[j].x + v[j].y * v[j].y) + (v[j].z * v[j].z + v[j].w * v[j].w); }
        const float rstd = 1.0f / sqrtf(wave_sum(s) * (1.0f / DM) + EPS);
        u32x2* o8 = (u32x2*)(XN + (size_t)m * DM) + lane;
#pragma unroll
        for (int j = 0; j < 4; ++j) { u32x2 w; w.x = pkh(v[j].x * rstd * gv[j].x, v[j].y * rstd * gv[j].y); w.y = pkh(v[j].z * rstd * gv[j].z, v[j].w * rstd * gv[j].w); o8[64 * j] = w; }
        const f32x4 pv = ((const f32x4*)(p + (size_t)m * DPLE))[lane]; u32x2 w; w.x = pkh(pv.x, pv.y); w.y = pkh(pv.z, pv.w);
        ((u32x2*)(P16 + (size_t)m * DPLE))[lane] = w;
    }
    if (blockIdx.x == 0) { const float* rb = a.in[8]; float* BT = (float*)(a.ws + WS_BT);
        for (int i = tid; i < 128 * 8; i += 512) { const int d = i >> 3, h = i & 7; BT[i] = (rb[t5_bucket(d) * 8 + h] - rb[31 * 8 + h]) * LOG2E; } }
}

__device__ __forceinline__ void phase_mlstm_naive(const Args& a, LAS unsigned char* lds, int blk) {
    LAS float* qs = (LAS float*)lds; LAS float* ks = (LAS float*)(lds + 32768); LAS float* vs = (LAS float*)(lds + 65536); LAS float* lis = (LAS float*)(lds + 73728); LAS float* lfs = (LAS float*)(lds + 73984);
    const int tid = threadIdx.x, lane = tid & 63, w = tid >> 6, vq = lane >> 4, dg = lane & 15, vv = 4 * w + vq;
    const int bh = blk >> 3, slice = blk & 7, b = bh >> 2, h = bh & 3;
    const h16* MQ = (const h16*)((unsigned char*)a.out + DO_MQ); const h16* MK = (const h16*)((unsigned char*)a.out + DO_MK); const h16* MV = (const h16*)((unsigned char*)a.out + DO_MV);
    const float* GT = (const float*)(a.ws + WS_GATES); const float* cw = a.in[4];
    float* HR = (float*)(a.ws + WS_H1);
    float C[8], n[8]; float m = 0.f;
#pragma unroll
    for (int i = 0; i < 8; ++i) { C[i] = 0.f; n[i] = 0.f; }
    for (int c = 0; c < SEQ / 64; ++c) {
        const int t0 = c * 64;
        __syncthreads();
        for (int i = tid; i < 64 * 256; i += 512) { const int tok = i >> 8, ch = i & 255; const bool isk = ch >= 128; const int d = ch & 127;
            const int chg = (isk ? 512 : 0) + h * 128 + d; const h16* src = (isk ? MK : MQ) + h * 128 + d; float y = 0.f;
#pragma unroll
            for (int j = 0; j < 4; ++j) { const int t = t0 + tok - 3 + j; if (t >= 0) y += cw[j * 1024 + chg] * (float)src[(size_t)(b * SEQ + t) * 512]; }
            y = siluf_(y); if (isk) ks[tok * 128 + d] = y * 0.08838834764831845f; else qs[tok * 128 + d] = y; }
        for (int i = tid; i < 64 * 32; i += 512) { const int tok = i >> 5, v = i & 31; vs[tok * 32 + v] = (float)MV[(size_t)(b * SEQ + t0 + tok) * 1024 + h * 256 + slice * 32 + v]; }
        if (tid < 64) { lis[tid] = GT[(size_t)(b * SEQ + t0 + tid) * 8 + h]; lfs[tid] = GT[(size_t)(b * SEQ + t0 + tid) * 8 + 4 + h]; }
        __syncthreads();
        for (int s = 0; s < 64; ++s) {
            const float lf = lfs[s], li = lis[s]; const float mn = fmaxf(lf + m, li); const float fd = expf(lf + m - mn), iw = expf(li - mn); m = mn;
            const float vval = vs[s * 32 + vv] * iw; float ph = 0.f, pn = 0.f;
#pragma unroll
            for (int i = 0; i < 8; ++i) { const float kd = ks[s * 128 + dg * 8 + i], qd = qs[s * 128 + dg * 8 + i]; C[i] = fd * C[i] + kd * vval; n[i] = fd * n[i] + iw * kd; ph += C[i] * qd; pn += n[i] * qd; }
#pragma unroll
            for (int o = 1; o < 16; o <<= 1) { ph += __shfl_xor(ph, o); pn += __shfl_xor(pn, o); }
            if (dg == 0) HR[(size_t)(b * SEQ + t0 + s) * 1024 + h * 256 + slice * 32 + vv] = ph / fmaxf(fabsf(pn), expf(-m));
        }
    }
    __syncthreads();
}

__device__ __forceinline__ void phase_headnorm(const Args& a, LAS unsigned char* lds) {
    LAS float* red = (LAS float*)lds;
    const int tid = threadIdx.x, lane = tid & 63, wave = tid >> 6, sub = tid >> 8, t2 = tid & 255;
    const float* HRb = (const float*)(a.ws + WS_H1); const h16* MGb = (const h16*)(a.ws + WS_MG); h16* MIXb = (h16*)((unsigned char*)a.out + DO_MIX); const float* mnb = a.in[7];
    for (int it = blockIdx.x * 2; it < M * 4; it += gridDim.x * 2) { const int pr = it + sub, row = pr >> 2, h = pr & 3;
        const float v = HRb[(size_t)row * 1024 + h * 256 + t2]; const float s = wave_sum(v * v);
        __syncthreads(); if (lane == 0) red[wave] = s; __syncthreads();
        const float tot = red[sub * 4] + red[sub * 4 + 1] + red[sub * 4 + 2] + red[sub * 4 + 3];
        MIXb[(size_t)row * DMIX + h * 256 + t2] = (h16)(v / sqrtf(tot / 256.f + EPS) * mnb[h * 256 + t2] * (float)MGb[(size_t)row * 1024 + h * 256 + t2]); }
    __syncthreads();
}

__device__ __forceinline__ void index_row_naive(const Args& a, LAS unsigned char* lds, int row) {
    LAS unsigned* keys = (LAS unsigned*)lds; LAS float* qf = (LAS float*)(lds + 32768); LAS unsigned* hist = (LAS unsigned*)(lds + 34816); LAS unsigned* sh = (LAS unsigned*)(lds + 35840);
    const int tid = threadIdx.x, b = row >> 13, t = row & (SEQ - 1);
    const h16* IQ = (const h16*)(a.ws + WS_IQ); const h16* IK = (const h16*)(a.ws + WS_IK); const float* IW = (const float*)(a.ws + WS_IW);
    unsigned* MASK = (unsigned*)(a.ws + WS_MASK) + (size_t)row * 256;
    if (t < 256) { if (tid < 256) { const int lo = tid * 32; unsigned wv = 0; if (t >= lo + 31) wv = 0xffffffffu; else if (t >= lo) wv = (2u << (t - lo)) - 1u; MASK[tid] = wv; } return; }
    __syncthreads();
    qf[tid] = (float)IQ[(size_t)row * 512 + tid];
    float wv[8];
#pragma unroll
    for (int hh = 0; hh < 8; ++hh) wv[hh] = IW[(size_t)row * 8 + hh];
    __syncthreads();
    for (int s = tid; s <= t; s += 512) {
        const h16x8* kr = (const h16x8*)(IK + (size_t)(b * SEQ + s) * 64); float dd[8];
#pragma unroll
        for (int hh = 0; hh < 8; ++hh) dd[hh] = 0.f;
#pragma unroll 1
        for (int j = 0; j < 8; ++j) { const h16x8 q8 = kr[j]; float k8[8];
#pragma unroll
            for (int i = 0; i < 8; ++i) k8[i] = (float)q8[i];
#pragma unroll
            for (int hh = 0; hh < 8; ++hh)
#pragma unroll
                for (int i = 0; i < 8; ++i) dd[hh] += qf[hh * 64 + 8 * j + i] * k8[i]; }
        float sc = 0.f;
#pragma unroll
        for (int hh = 0; hh < 8; ++hh) sc += wv[hh] * fmaxf(dd[hh], 0.f);
        sc += 0.0f;
        const unsigned u = __float_as_uint(sc); keys[s] = (u & 0x80000000u) ? ~u : (u | 0x80000000u);
    }
    unsigned prefix = 0; int krem = 256; unsigned neq = 0;
    for (int pass = 0; pass < 4; ++pass) { const int shift = 24 - 8 * pass;
        if (tid < 256) hist[tid] = 0;
        __syncthreads();
        for (int s = tid; s <= t; s += 512) { const unsigned k = keys[s]; if (pass == 0 || (k >> (shift + 8)) == prefix) __hip_atomic_fetch_add(hist + ((k >> shift) & 255u), 1u, __ATOMIC_RELAXED, __HIP_MEMORY_SCOPE_WORKGROUP); }
        __syncthreads();
        if (tid == 0) { int cum = 0; int d = 255; for (; d > 0; --d) { const int c = (int)hist[d]; if (cum + c >= krem) break; cum += c; } sh[0] = (unsigned)d; sh[1] = (unsigned)(krem - cum); sh[2] = hist[d]; }
        __syncthreads();
        prefix = (prefix << 8) | sh[0]; krem = (int)sh[1]; neq = sh[2];
        __syncthreads();
    }
    const unsigned tau = prefix; int idx_lim = SEQ;
    if ((int)neq != krem) { if (tid == 0) { int cnt = 0, lim = 0; for (int s = 0; s <= t; ++s) if (keys[s] == tau) { if (++cnt == krem) { lim = s; break; } } sh[3] = (unsigned)lim; }
        __syncthreads(); idx_lim = (int)sh[3]; }
    if (tid < 256) { unsigned wv2 = 0; const int lo = tid * 32;
        for (int i = 0; i < 32; ++i) { const int s = lo + i; if (s <= t) { const unsigned k = keys[s]; if (k > tau || (k == tau && s <= idx_lim)) wv2 |= 1u << i; } }
        MASK[tid] = wv2; }
}

__device__ __forceinline__ void attn_row_naive(const Args& a, int row) {
    const int tid = threadIdx.x, lane = tid & 63, h = tid >> 6, b = row >> 13, t = row & (SEQ - 1);
    const h16* AQ = (const h16*)(a.ws + WS_AQ); const h16* AK = (const h16*)(a.ws + WS_AK); const h16* AV = (const h16*)(a.ws + WS_AV); const h16* AZ = (const h16*)(a.ws + WS_AZ);
    const unsigned* MASK = (const unsigned*)(a.ws + WS_MASK) + (size_t)row * 256; const float* BT = (const float*)(a.ws + WS_BT);
    h16* MIX = (h16*)((unsigned char*)a.out + DO_MIX);
    const float q = (float)AQ[(size_t)row * 512 + h * 64 + lane];
    float mx = -1e30f, l = 0.f, o = 0.f;
    const int nw = (t >> 5) + 1;
    for (int w = 0; w < nw; ++w) { unsigned word = MASK[w];
        while (word) { const int bit = __builtin_ctz(word); word &= word - 1; const int s = w * 32 + bit;
            const size_t kr = (size_t)(b * SEQ + s) * 512 + h * 64 + lane;
            const float kv = (float)AK[kr], vv = (float)AV[kr];
            const int dist = t - s; const float x = wave_sum(q * kv) + BT[(dist < 127 ? dist : 127) * 8 + h];
            const float mn = fmaxf(mx, x); const float f = exp2f(mx - mn), p = exp2f(x - mn); l = l * f + p; o = o * f + p * vv; mx = mn; } }
    const float r = o / l * (float)AZ[(size_t)row * 512 + h * 64 + lane];
    MIX[(size_t)row * DMIX + 1024 + h * 64 + lane] = (h16)r;
}

__device__ __forceinline__ void phase_tail(const Args& a) {
    const int lane = threadIdx.x & 63, gw = blockIdx.x * 8 + (threadIdx.x >> 6), NGW = gridDim.x * 8;
    const float* H1 = (const float*)(a.ws + WS_H1); const h16* PB = (const h16*)(a.ws + WS_PB); const float* gf = a.in[11];
    f32x4 gv[4];
#pragma unroll
    for (int j = 0; j < 4; ++j) gv[j] = ((const f32x4*)gf)[lane + 64 * j];
    for (int m = gw; m < M; m += NGW) {
        const f32x4* hr = (const f32x4*)(H1 + (size_t)m * DM) + lane; const h16x4* pr = (const h16x4*)(PB + (size_t)m * DM) + lane; f32x4* o = (f32x4*)(a.out + (size_t)m * DM) + lane;
        f32x4 v[4]; float s = 0.f;
#pragma unroll
        for (int j = 0; j < 4; ++j) { const f32x4 hv = hr[64 * j], g = o[64 * j]; const h16x4 p4 = pr[64 * j];
            v[j].x = hv.x + (float)p4[0] * sigmoidf_(g.x); v[j].y = hv.y + (float)p4[1] * sigmoidf_(g.y); v[j].z = hv.z + (float)p4[2] * sigmoidf_(g.z); v[j].w = hv.w + (float)p4[3] * sigmoidf_(g.w);
            s += (v[j].x * v[j].x + v[j].y * v[j].y) + (v[j].z * v[j].z + v[j].w * v[j].w); }
        const float rstd = 1.0f / sqrtf(wave_sum(s) * (1.0f / DM) + EPS);
        float pen = 0.f;
#if DEBUG_CHECKS
        { const unsigned* flags = (const unsigned*)(a.ws + WS_FLAGS); for (int i = 0; i < 12; ++i) if (i != 8 && __uint_as_float(flags[i]) > 1.0f) pen += (float)(1 << i); }
#endif
#pragma unroll
        for (int j = 0; j < 4; ++j) o[64 * j] = v[j] * rstd * gv[j] + pen;
    }
}

namespace mls {
using f32x16 = __attribute__((ext_vector_type(16))) float;
typedef __attribute__((address_space(3))) const char* lcp;
typedef __attribute__((address_space(3))) char* lp;
constexpr int LDQ = 272, LDT = 144;
constexpr int O_QS = 0, O_QW = 17408, O_KS = 34816, O_KTW = 52224, O_VT = 70656, O_PS = 75264, O_CT = 84480, O_G = 101888, O_N = 103424, O_QN = 103936, O_DEN = 104192, MLS_LDS = 104448;
__device__ __forceinline__ int crow(int r, int hi) { return (r & 3) + 8 * (r >> 2) + 4 * hi; }
__device__ __forceinline__ void mma_tile(f32x16& acc, lcp A, int lda, lcp B, int ldb, int ksteps, int r32, int hi) {
    const lcp ap = A + r32 * lda + hi * 16, bp = B + r32 * ldb + hi * 16;
    for (int k = 0; k < ksteps; ++k) { const h16x8 a = *(const LAS h16x8*)(ap + k * 32), b = *(const LAS h16x8*)(bp + k * 32); acc = __builtin_amdgcn_mfma_f32_32x32x16_f16(a, b, acc, 0, 0, 0); }
}
__device__ __forceinline__ void phase_mlstm(const Args& a, LAS unsigned char* ldsb, int blk) {
    const lp lds = (lp)ldsb;
    const int tid = threadIdx.x, lane = tid & 63, r32 = lane & 31, hi = lane >> 5; const int wid = __builtin_amdgcn_readfirstlane(tid >> 6);
    const int bh = blk >> 3, slice = blk & 7, b = bh >> 2, h = bh & 3;
    const h16* MQ = (const h16*)((unsigned char*)a.out + DO_MQ); const h16* MK = (const h16*)((unsigned char*)a.out + DO_MK); const h16* MV = (const h16*)((unsigned char*)a.out + DO_MV);
    const float* GT = (const float*)(a.ws + WS_GATES); const float* cw = a.in[4];
    float* HR = (float*)(a.ws + WS_H1);
    LAS float* Gs = (LAS float*)(lds + O_G);
    LAS float* nv = (LAS float*)(lds + O_N); LAS float* qn = (LAS float*)(lds + O_QN); LAS float* denv = (LAS float*)(lds + O_DEN);
    const int ch = tid & 255, half = tid >> 8, isk = ch >> 7, dch = ch & 127;
    const h16* rawp = (isk ? MK : MQ) + (size_t)b * SEQ * 512 + h * 128 + dch;
    float cwv[4];
#pragma unroll
    for (int j = 0; j < 4; ++j) cwv[j] = cw[j * 1024 + isk * 512 + h * 128 + dch];
    const int vtok = tid >> 3, v4 = (tid & 7) * 4;
    const h16* vp = MV + (size_t)b * SEQ * 1024 + h * 256 + slice * 32 + v4;
    for (int i = tid; i < (O_G - O_PS) / 4; i += 512) ((LAS unsigned*)(lds + O_PS))[i] = 0u;
    if (tid < 128) nv[tid] = 0.f;
    f32x16 Cacc;
#pragma unroll
    for (int r = 0; r < 16; ++r) Cacc[r] = 0.f;
    float m_prev = 0.f; int cur = 0;
    h16 raw[35]; h16x4 vraw; float lf_n, li_n;
#pragma unroll
    for (int i = 0; i < 35; ++i) { const int t = 32 * half - 3 + i; raw[i] = (t >= 0) ? rawp[(size_t)t * 512] : (h16)0.f; }
    vraw = *(const h16x4*)(vp + (size_t)vtok * 1024);
    lf_n = GT[(size_t)(b * SEQ + lane) * 8 + 4 + h]; li_n = GT[(size_t)(b * SEQ + lane) * 8 + h];
    __syncthreads();
    for (int c = 0; c < SEQ / 64; ++c) {
        const int t0 = c * 64;
        const float lf = lf_n, li = li_n;
        float bq = lf;
#pragma unroll
        for (int o = 1; o < 64; o <<= 1) { const float t = __shfl_up(bq, o); if (lane >= o) bq += t; }
        const float av = li - bq; float A = av;
#pragma unroll
        for (int o = 1; o < 64; o <<= 1) { const float t = __shfl_up(A, o); if (lane >= o) A = fmaxf(A, t); }
        const float g = fmaxf(m_prev, A);
        const float g63 = __shfl(g, 63), bL = __shfl(bq, 63);
        const float winter = __expf(m_prev - g), wk = __expf(av - g63), decay = __expf(m_prev - g63);
        if (wid == 0) { Gs[lane] = av; Gs[64 + lane] = g; Gs[128 + lane] = __expf(-(bq + g)); }
        {
            const lp rowb = lds + (isk ? O_KS : O_QS) + (32 * half) * LDQ + dch * 2;
            const lp auxb = isk ? (lds + O_KTW + dch * LDT + (32 * half) * 2) : (lds + O_QW + (32 * half) * LDQ + dch * 2);
#pragma unroll
            for (int i = 0; i < 32; ++i) { float y = cwv[0] * (float)raw[i] + cwv[1] * (float)raw[i + 1] + cwv[2] * (float)raw[i + 2] + cwv[3] * (float)raw[i + 3]; y = siluf_(y);
                const int tok = 32 * half + i;
                if (isk) { y *= 0.08838834764831845f; *(LAS h16*)(rowb + i * LDQ) = (h16)y; *(LAS h16*)(auxb + i * 2) = (h16)(y * __shfl(wk, tok)); }
                else { *(LAS h16*)(rowb + i * LDQ) = (h16)y; *(LAS h16*)(auxb + i * LDQ) = (h16)(y * __shfl(winter, tok)); } }
#pragma unroll
            for (int j = 0; j < 4; ++j) *(LAS h16*)(lds + O_VT + (v4 + j) * LDT + vtok * 2) = vraw[j];
        }
        __syncthreads();
        if (c + 1 < SEQ / 64) {
#pragma unroll
            for (int i = 0; i < 35; ++i) { const int t = t0 + 64 + 32 * half - 3 + i; raw[i] = rawp[(size_t)t * 512]; }
            vraw = *(const h16x4*)(vp + (size_t)(t0 + 64 + vtok) * 1024);
            lf_n = GT[(size_t)(b * SEQ + t0 + 64 + lane) * 8 + 4 + h]; li_n = GT[(size_t)(b * SEQ + t0 + 64 + lane) * 8 + h];
        }
        if (wid < 3) {
            const int lb = wid ? 1 : 0, sb = wid == 2 ? 1 : 0;
            f32x16 S;
#pragma unroll
            for (int r = 0; r < 16; ++r) S[r] = 0.f;
            mma_tile(S, lds + O_QS + lb * 32 * LDQ, LDQ, lds + O_KS + sb * 32 * LDQ, LDQ, 8, r32, hi);
            const float as = Gs[32 * sb + r32]; const int spos = 32 * sb + r32;
            const LAS float* gb = Gs + 64 + 32 * lb + 4 * hi; const lp pb = lds + O_PS + (32 * lb + 4 * hi) * LDT + spos * 2; const int l0 = 32 * lb + 4 * hi;
#pragma unroll
            for (int r = 0; r < 16; ++r) { const int ro = (r & 3) + 8 * (r >> 2); const float p = (spos <= l0 + ro) ? S[r] * __expf(as - gb[ro]) : 0.f;
                *(LAS h16*)(pb + ro * LDT) = (h16)p; }
        } else if (wid < 7) {
            const int j = wid - 3;
#pragma unroll
            for (int r = 0; r < 16; ++r) Cacc[r] *= decay;
            mma_tile(Cacc, lds + O_VT, LDT, lds + O_KTW + j * 32 * LDT, LDT, 4, r32, hi);
            const lp cb = lds + O_CT + (cur ^ 1) * 8704 + (4 * hi) * LDQ + (32 * j + r32) * 2;
#pragma unroll
            for (int r = 0; r < 16; ++r) *(LAS h16*)(cb + ((r & 3) + 8 * (r >> 2)) * LDQ) = (h16)Cacc[r];
        } else {
            float s = 0.f;
            for (int d8 = 0; d8 < 16; ++d8) { const h16x8 q8 = *(const LAS h16x8*)(lds + O_QW + lane * LDQ + d8 * 16);
#pragma unroll
                for (int j = 0; j < 8; ++j) s += (float)q8[j] * nv[8 * d8 + j]; }
            qn[lane] = s;
            asm volatile("s_waitcnt lgkmcnt(0)" ::: "memory");
#pragma unroll
            for (int hh = 0; hh < 2; ++hh) { const int d = lane + 64 * hh; float ks = 0.f;
                for (int s8 = 0; s8 < 8; ++s8) { const h16x8 k8 = *(const LAS h16x8*)(lds + O_KTW + d * LDT + s8 * 16);
#pragma unroll
                    for (int j = 0; j < 8; ++j) ks += (float)k8[j]; }
                nv[d] = decay * nv[d] + ks; }
        }
        __syncthreads();
        f32x16 N;
        if (wid < 2) {
#pragma unroll
            for (int r = 0; r < 16; ++r) N[r] = 0.f;
            mma_tile(N, lds + O_PS + wid * 32 * LDT, LDT, lds + O_VT, LDT, 2 + 2 * wid, r32, hi);
            mma_tile(N, lds + O_QW + wid * 32 * LDQ, LDQ, lds + O_CT + cur * 8704, LDQ, 8, r32, hi);
        } else if (wid == 2) {
            float s = 0.f;
            for (int s8 = 0; s8 < 8; ++s8) { const h16x8 p8 = *(const LAS h16x8*)(lds + O_PS + lane * LDT + s8 * 16);
#pragma unroll
                for (int j = 0; j < 8; ++j) s += (float)p8[j]; }
            denv[lane] = fmaxf(fabsf(s + qn[lane]), Gs[128 + lane]);
        }
        __syncthreads();
        if (wid < 2) {
            const LAS float* db = denv + 32 * wid + 4 * hi; float* hb = HR + (size_t)(b * SEQ + t0 + 32 * wid + 4 * hi) * 1024 + h * 256 + slice * 32 + r32;
#pragma unroll
            for (int r = 0; r < 16; ++r) { const int ro = (r & 3) + 8 * (r >> 2); hb[(size_t)ro * 1024] = N[r] / db[ro]; }
        }
        m_prev = bL + g63; cur ^= 1;
        __syncthreads();
    }
}
}

namespace idx {
using f32x16 = __attribute__((ext_vector_type(16))) float;
typedef __attribute__((address_space(3))) char* lp;
constexpr int IDX_CAP = 256;
constexpr int O_HIST = 0;
constexpr int O_LIST = 0, O_IMG = 65536;
constexpr int O_QF = 98304, O_W = 131072 + 1024;
constexpr int O_MISC = 131072 + 2048;
__device__ __forceinline__ int crow(int r, int hi) { return (r & 3) + 8 * (r >> 2) + 4 * hi; }
__device__ __forceinline__ int bin_of(float x) {
    const unsigned u = __float_as_uint(x); int e5 = (int)((u & 0x7fffffffu) >> 18) - 3744; e5 = e5 < 0 ? 0 : (e5 > 511 ? 511 : e5);
    return (u >> 31) ? 511 - e5 : 512 + e5;
}
__device__ __forceinline__ void load_kfrag(h16x8 (&af)[4], const h16* IKb, int kb, int r32, int hi) {
    const h16* p = IKb + (size_t)(32 * kb + r32) * 64 + 8 * hi;
#pragma unroll
    for (int k = 0; k < 4; ++k) af[k] = *(const h16x8*)(p + 16 * k);
}
__device__ __forceinline__ void score_block(f32x16& sc, const h16x8 (&af)[4], lp qimg, lp wimg) {
#pragma unroll
    for (int r = 0; r < 16; ++r) sc[r] = 0.f;
#pragma unroll 1
    for (int h = 0; h < 8; ++h) { f32x16 acc;
#pragma unroll
        for (int r = 0; r < 16; ++r) acc[r] = 0.f;
        const float wh = *(const LAS float*)(wimg + h * 128);
#pragma unroll
        for (int k = 0; k < 4; ++k) { const h16x8 qf = *(const LAS h16x8*)(qimg + (h * 4 + k) * 1024); acc = __builtin_amdgcn_mfma_f32_32x32x16_f16(af[k], qf, acc, 0, 0, 0); }
#pragma unroll
        for (int r = 0; r < 16; ++r) sc[r] = fmaf(wh, fmaxf(acc[r], 0.f), sc[r]); }
#pragma unroll
    for (int r = 0; r < 16; ++r) sc[r] += 0.0f;
}
__device__ __forceinline__ void hist_add(LAS unsigned* hist, int q, int bin) { __hip_atomic_fetch_add(hist + q * 512 + ((bin >> 1) ^ q), 1u << (16 * (bin & 1)), __ATOMIC_RELAXED, __HIP_MEMORY_SCOPE_WORKGROUP); }
__device__ __forceinline__ unsigned hist_get(const LAS unsigned* hist, int q, int bin) { return (hist[q * 512 + ((bin >> 1) ^ q)] >> (16 * (bin & 1))) & 0xffffu; }
__device__ __forceinline__ void index_unit(const Args& a, LAS unsigned char* ldsb, int b, int qblk) {
    const lp lds = (lp)ldsb;
    const int tid = threadIdx.x, lane = tid & 63, r32 = lane & 31, hi = lane >> 5; const int wid = __builtin_amdgcn_readfirstlane(tid >> 6);
    const h16* IQ = (const h16*)(a.ws + WS_IQ); const h16* IKb = (const h16*)(a.ws + WS_IK) + (size_t)b * SEQ * 64; const float* IW = (const float*)(a.ws + WS_IW);
    unsigned long long* MB = (unsigned long long*)(a.ws + WS_MASKB) + ((size_t)(b * 256 + qblk) * 256) * 16;
    LAS unsigned* hist = (LAS unsigned*)(lds + O_HIST); LAS unsigned long long* list = (LAS unsigned long long*)(lds + O_LIST); LAS unsigned long long* img = (LAS unsigned long long*)(lds + O_IMG);
    LAS int* bstar = (LAS int*)(lds + O_MISC); LAS int* cabove = bstar + 32; LAS unsigned* cnt = (LAS unsigned*)(bstar + 64);
    const int q0 = 32 * qblk, kblim = (qblk | 7);
    if (qblk < 8) {
        for (int kb = wid; kb <= kblim; kb += 8) { unsigned long long mine = 0ull;
#pragma unroll
            for (int r = 0; r < 16; ++r) { const unsigned long long bal = __ballot(32 * kb + crow(r, hi) <= q0 + r32); if (lane == r) mine = bal; }
            if (lane < 16) MB[(size_t)kb * 16 + lane] = mine; }
        return;
    }
    { const int pr = tid >> 1;
#pragma unroll
      for (int i = 0; i < 4; ++i) { const int piece = tid * 4 + i, rq = piece & 31, hh = (piece >> 5) & 1, k = (piece >> 6) & 3, h = piece >> 8;
          *(LAS h16x8*)(lds + O_QF + piece * 16) = *(const h16x8*)(IQ + (size_t)(b * SEQ + q0 + rq) * 512 + h * 64 + 16 * k + 8 * hh); }
      (void)pr;
      if (tid < 256) *(LAS float*)(lds + O_W + (tid & 7) * 128 + (tid >> 3) * 4) = IW[(size_t)(b * SEQ + q0 + (tid >> 3)) * 8 + (tid & 7)]; }
    const lp qimg = lds + O_QF + hi * 512 + r32 * 16, wimg = lds + O_W + r32 * 4;
    const int tq = q0 + r32;
    { u32x4* hz = (u32x4*)(lds + O_HIST);
#pragma unroll
      for (int i = 0; i < 8; ++i) *(LAS u32x4*)(lds + O_HIST + (tid + 512 * i) * 16) = (u32x4){0, 0, 0, 0};
      (void)hz; }
    __syncthreads();
    { h16x8 af[4], afn[4]; f32x16 sc;
      if (wid <= qblk) load_kfrag(af, IKb, wid, r32, hi);
      for (int kb = wid; kb <= qblk; kb += 8) {
          if (kb + 8 <= qblk) load_kfrag(afn, IKb, kb + 8, r32, hi);
          score_block(sc, af, qimg, wimg);
#pragma unroll
          for (int r = 0; r < 16; ++r) { const int key = 32 * kb + crow(r, hi);
              if (key <= tq) hist_add(hist, r32, bin_of(sc[r])); }
#pragma unroll
          for (int k = 0; k < 4; ++k) af[k] = afn[k];
      } }
    __syncthreads();
    { const int q = tid >> 4, seg = tid & 15; unsigned s = 0;
      for (int i = 0; i < 64; ++i) s += hist_get(hist, q, 64 * seg + i);
      unsigned above = 0;
#pragma unroll
      for (int o = 1; o < 16; ++o) { const unsigned t = __shfl(s, (lane & 48) | ((seg + o) & 15)); if (seg + o < 16) above += t; }
      if (above < 256u && above + s >= 256u) { unsigned cum = above; int bsel = 64 * seg;
          for (int i = 63; i >= 0; --i) { const unsigned c = hist_get(hist, q, 64 * seg + i); if (cum + c >= 256u) { bsel = 64 * seg + i; break; } cum += c; }
          bstar[q] = bsel; cabove[q] = (int)cum; }
      if (tid < 32) cnt[tid] = 0u; }
    __syncthreads();
    { h16x8 af[4], afn[4]; f32x16 sc; const int bs = bstar[r32];
      if (wid <= qblk) load_kfrag(af, IKb, wid, r32, hi);
      for (int kb = wid; kb <= qblk; kb += 8) {
          if (kb + 8 <= qblk) load_kfrag(afn, IKb, kb + 8, r32, hi);
          score_block(sc, af, qimg, wimg);
          unsigned long long mine = 0ull;
#pragma unroll
          for (int r = 0; r < 16; ++r) { const int key = 32 * kb + crow(r, hi); const int bn = bin_of(sc[r]); const bool valid = key <= tq;
              const unsigned long long bal = __ballot(valid && bn > bs); if (lane == r) mine = bal;
              if (valid && bn == bs) { const unsigned pos = __hip_atomic_fetch_add(cnt + r32, 1u, __ATOMIC_RELAXED, __HIP_MEMORY_SCOPE_WORKGROUP);
                  const unsigned u = __float_as_uint(sc[r]); const unsigned ok = (u & 0x80000000u) ? ~u : (u | 0x80000000u);
                  if (pos < (unsigned)IDX_CAP) list[r32 * IDX_CAP + pos] = ((unsigned long long)ok << 32) | (unsigned)(0xffffffffu - (unsigned)key); } }
          if (lane < 16) img[kb * 16 + lane] = mine;
#pragma unroll
          for (int k = 0; k < 4; ++k) af[k] = afn[k];
      }
      for (int kb = qblk + 1 + wid; kb <= kblim; kb += 8) if (lane < 16) img[kb * 16 + lane] = 0ull; }
    __syncthreads();
    { const int q = tid >> 4, seg = tid & 15; const int n = (int)min(cnt[q], (unsigned)IDX_CAP), need = 256 - cabove[q];
      for (int i = seg; i < n; i += 16) { const unsigned long long e = list[q * IDX_CAP + i]; int rank = 0;
          for (int j = 0; j < n; ++j) rank += (list[q * IDX_CAP + j] > e) ? 1 : 0;
          if (rank < need) { const unsigned key = 0xffffffffu - (unsigned)(e & 0xffffffffu); const int kk = key & 31, kb = key >> 5, h2 = (kk >> 2) & 1, r = (kk & 3) + 4 * (kk >> 3);
              __hip_atomic_fetch_or((LAS unsigned*)(img + kb * 16 + r) + h2, 1u << q, __ATOMIC_RELAXED, __HIP_MEMORY_SCOPE_WORKGROUP); } } }
    __syncthreads();
    for (int i = tid; i < (kblim + 1) * 16; i += 512) MB[i] = img[i];
    __syncthreads();
}
__device__ __forceinline__ void phase_index(const Args& a, LAS unsigned char* lds) {
    unsigned* qhead = (unsigned*)(a.ws + WS_CTL) + 2048; LAS unsigned* uslot = (LAS unsigned*)(lds + O_MISC + 512);
    for (;;) {
        if (threadIdx.x == 0) *uslot = __hip_atomic_fetch_add(qhead, 1u, __ATOMIC_RELAXED, __HIP_MEMORY_SCOPE_AGENT);
        __syncthreads();
        const unsigned u = *uslot;
        __syncthreads();
        if (u >= 512u) break;
        index_unit(a, lds, (int)(u & 1u), 255 - (int)(u >> 1));
    }
}
}

namespace attn_body {
using s16x4=__attribute__((ext_vector_type(4)))short;
using f32x16=__attribute__((ext_vector_type(16)))float;
constexpr int NHEAD=8,D=64,APITCH=512;
constexpr int NW=8,QBLK=32,QB=QBLK*NW,KVBLK=64;
__device__ __forceinline__ int crow(int r,int hi){return (r&3)+8*(r>>2)+4*hi;}
#define SBAR() __builtin_amdgcn_sched_barrier(0)
constexpr int NSLOT=3, SLOTB=8192;
constexpr int LDS_K=0, LDS_V=NSLOT*SLOTB, LDS_WS=2*NSLOT*SLOTB, LDS_OST=LDS_WS+NW*64*4, LDS_BT=LDS_OST+NW*4096, LDS_BYTES=LDS_BT+128*4;
__device__ __forceinline__ void glds16(const void*gsrc,unsigned lds_dst){unsigned keep;
  asm volatile("s_mov_b32 %0, m0\n\ts_mov_b32 m0, %2\n\ts_nop 0\n\tglobal_load_lds_dwordx4 %1, off\n\ts_mov_b32 m0, %0":"=&s"(keep):"v"(gsrc),"s"(lds_dst):"memory");}
__device__ __forceinline__ float max3f(float a,float b,float c){float r;asm("v_max3_f32 %0, %1, %2, %3":"=v"(r):"v"(a),"v"(b),"v"(c));return r;}
__device__ __forceinline__ float max2f(float a,float b){float r;asm("v_max_f32_e32 %0, %1, %2":"=v"(r):"v"(a),"v"(b));return r;}
__device__ __forceinline__ float fadd_s(float a,float b){float r;asm("v_add_f32_e32 %0, %1, %2":"=v"(r):"v"(a),"v"(b));return r;}
__device__ __forceinline__ float fsub_s(float a,float b){float r;asm("v_sub_f32_e32 %0, %1, %2":"=v"(r):"v"(a),"v"(b));return r;}
__device__ __forceinline__ unsigned cvtpk_s(float lo,float hi){f32x2 v={lo,hi};h16x2 b=__builtin_convertvector(v,h16x2);return __builtin_bit_cast(unsigned,b);}
#define WAIT_BAR(N) asm volatile("s_waitcnt vmcnt(" #N ") lgkmcnt(0)\n\ts_barrier":::"memory")
#define MFMA16(a,b,c) __builtin_amdgcn_mfma_f32_32x32x16_f16(a,b,c,0,0,0)
typedef __attribute__((address_space(3))) const char* lds_cptr;
typedef short v4i16_t __attribute__((ext_vector_type(4)));
__device__ __forceinline__ void kload8(h16x8*kf,lds_cptr kp){
  kf[0]=*(const __attribute__((address_space(3))) h16x8*)(kp);      kf[1]=*(const __attribute__((address_space(3))) h16x8*)(kp+512);
  kf[2]=*(const __attribute__((address_space(3))) h16x8*)(kp+2048); kf[3]=*(const __attribute__((address_space(3))) h16x8*)(kp+2560);
  kf[4]=*(const __attribute__((address_space(3))) h16x8*)(kp+4096); kf[5]=*(const __attribute__((address_space(3))) h16x8*)(kp+4608);
  kf[6]=*(const __attribute__((address_space(3))) h16x8*)(kp+6144); kf[7]=*(const __attribute__((address_space(3))) h16x8*)(kp+6656);
}
__device__ __forceinline__ void kload2(h16x8*kf,lds_cptr kp,int j){ kf[2*j]=*(const __attribute__((address_space(3))) h16x8*)(kp+j*2048); kf[2*j+1]=*(const __attribute__((address_space(3))) h16x8*)(kp+j*2048+512); }
__device__ __forceinline__ s16x4 vtr(lds_cptr p){ return __builtin_bit_cast(s16x4,__builtin_amdgcn_ds_read_tr16_b64_v4i16((__attribute__((address_space(3))) v4i16_t*)p)); }
__device__ __forceinline__ h16x8 vfr(s16x4 lo,s16x4 hi){ return __builtin_bit_cast(h16x8,__builtin_shufflevector(lo,hi,0,1,2,3,4,5,6,7)); }
__device__ __forceinline__ void qkt(f32x16&p0,f32x16&p1,const char*Kslot,const h16x8*qr,int r32,int hi){ const f32x16 negm=f32x16{};
  const char*kb=Kslot+hi*1024+r32*16;
  #pragma unroll
  for(int d0=0;d0<4;++d0){
    const h16x8 b0=*reinterpret_cast<const h16x8*>(kb+d0*2048);
    const h16x8 b1=*reinterpret_cast<const h16x8*>(kb+d0*2048+512);
    if(d0==0){p0=MFMA16(b0,qr[0],negm);p1=MFMA16(b1,qr[0],negm);}
    else{p0=MFMA16(b0,qr[d0],p0);p1=MFMA16(b1,qr[d0],p1);}}
}
__device__ __forceinline__ float rowmax(const f32x16&p0,const f32x16&p1){
  float a=max3f(p0[0],p0[1],p1[0]),b=max3f(p0[2],p0[3],p1[1]);a=max3f(a,p1[2],p1[3]);
  #pragma unroll
  for(int r=4;r<16;r+=4){a=max3f(a,p0[r],p0[r+1]);b=max3f(b,p0[r+2],p0[r+3]);a=max3f(a,p1[r],p1[r+1]);b=max3f(b,p1[r+2],p1[r+3]);}
  const float m=max2f(a,b);
  auto rr=__builtin_amdgcn_permlane32_swap(__float_as_uint(m),__float_as_uint(m),false,false);
  return max2f(__uint_as_float(rr[0]),__uint_as_float(rr[1]));
}
__device__ __forceinline__ void pv(f32x16*o,int vb,h16x8 pa0,h16x8 pa1,h16x8 pa2,h16x8 pa3){
  #pragma unroll
  for(int d0=0;d0<2;++d0){s16x4 lo[4],hi[4];
    #pragma unroll
    for(int ks=0;ks<4;++ks){
      asm volatile("ds_read_b64_tr_b16 %0,%1 offset:%c2":"=&v"(lo[ks]):"v"(vb),"i"(d0*4096+ks*1024):"memory");
      asm volatile("ds_read_b64_tr_b16 %0,%1 offset:%c2":"=&v"(hi[ks]):"v"(vb),"i"(d0*4096+ks*1024+512):"memory");}
    asm volatile("s_waitcnt lgkmcnt(0)":::"memory");SBAR();
    o[d0]=MFMA16(pa0,vfr(lo[0],hi[0]),o[d0]);
    o[d0]=MFMA16(pa1,vfr(lo[1],hi[1]),o[d0]);
    o[d0]=MFMA16(pa2,vfr(lo[2],hi[2]),o[d0]);
    o[d0]=MFMA16(pa3,vfr(lo[3],hi[3]),o[d0]);
  }
}
typedef const __attribute__((address_space(4))) unsigned long long* cptr64;
__device__ __forceinline__ void amask(f32x16&p0,f32x16&p1,cptr64 mp){
  const float NEG=-INFINITY;
  #pragma unroll
  for(int g=0;g<2;++g){ asm volatile("":"+s"(mp),"+v"(p0));
    #pragma unroll
    for(int r=0;r<8;++r){ p0[8*g+r]=__builtin_amdgcn_inverse_ballot_w64(mp[8*g+r])?p0[8*g+r]:NEG; } }
  #pragma unroll
  for(int g=0;g<2;++g){ asm volatile("":"+s"(mp),"+v"(p1),"+v"(p0));
    #pragma unroll
    for(int r=0;r<8;++r){ p1[8*g+r]=__builtin_amdgcn_inverse_ballot_w64(mp[16+8*g+r])?p1[8*g+r]:NEG; } }
}
__device__ __forceinline__ void abias(f32x16&p0,f32x16&p1,const float*bt,int qpos,int kbase,int hi){
  #pragma unroll
  for(int r=0;r<16;++r){ int d0=qpos-(kbase+(r&3)+8*(r>>2)+4*hi); int d1=d0-32; d0=d0<0?0:(d0>127?127:d0); d1=d1<0?0:(d1>127?127:d1); p0[r]+=bt[d0]; p1[r]+=bt[d1]; }
}

template<int THRL> __device__ __forceinline__ void attn_unit(int b,int h,int qb,const h16*Q,const h16*__restrict__ K,const h16*__restrict__ V,const h16*AZ,h16*MIXO,const unsigned long long*MASKB,const float*BT,char*shm){
  const int tid=threadIdx.x,lane=tid&63,r32=lane&31,hi=lane>>5; const int wid=__builtin_amdgcn_readfirstlane(tid>>6);
  const long rowbase=(long)b*SEQ; const int q0=qb*QB;
  const h16*Qw=Q+(rowbase+q0+wid*QBLK)*APITCH+h*D;
  const h16*Kh=K+rowbase*APITCH+h*D,*Vh=V+rowbase*APITCH+h*D;
  const unsigned lds0=(unsigned)(uintptr_t)shm;
  float*wsf=(float*)(shm+LDS_WS)+wid*64;
  float*btl=(float*)(shm+LDS_BT);
  if(tid<128)btl[tid]=BT[tid*8+h];
  const h16*ksrc=Kh+(long)lane*APITCH+wid*8;
  const h16*vsrc=Vh+(long)(16*(wid&3)+(lane>>2))*APITCH+(wid>>2)*32+(lane&3)*8;
  const unsigned kdst=lds0+LDS_K+wid*1024, vdst=lds0+LDS_V+wid*1024;
  #define DMA_K(t,slot) glds16(ksrc+(long)(t)*KVBLK*APITCH,(unsigned)__builtin_amdgcn_readfirstlane(kdst+(slot)))
  #define DMA_V(t,slot) glds16(vsrc+(long)(t)*KVBLK*APITCH,(unsigned)__builtin_amdgcn_readfirstlane(vdst+(slot)))
  const int vb0=(int)(lds0+LDS_V)+((lane>>4)&1)*32+(lane&3)*8+(4*hi+((lane&15)>>2))*64;
  const char*Kbase=shm+LDS_K; h16x8 kf[8];
  const lds_cptr shm3=(lds_cptr)shm; const lds_cptr kp0=shm3+LDS_K+hi*1024+r32*16; const lds_cptr vp0=shm3+LDS_V+((lane>>4)&1)*32+(lane&3)*8+(4*hi+((lane&15)>>2))*64;
  const int NT=(q0+QB)/KVBLK;
  const cptr64 mrow=(cptr64)(MASKB+((size_t)(b*256+(q0>>5)+wid)*256)*16);
  DMA_K(0,0);DMA_V(0,0);DMA_K(1,SLOTB);
  h16x8 qr[4];
  #pragma unroll
  for(int d0=0;d0<4;++d0)qr[d0]=*reinterpret_cast<const h16x8*>(&Qw[(long)r32*APITCH+d0*16+hi*8]);
  float mhat=0.f,l_reg=0.f;f32x16 o[2];o[0]=f32x16{};o[1]=f32x16{};
  const int qpos=q0+wid*QBLK+r32;
  #define AMASK(P0,P1,tt) do{ amask(P0,P1,mrow+(size_t)(tt)*32); if(NEARF(tt)) abias(P0,P1,btl,qpos,(tt)*KVBLK,hi); }while(0)
  bool resc=false;
  #define NEARF(tt) (NT<=6)
  #define START(P0,P1) do{ float rm=rowmax(P0,P1); rm=max2f(rm,-1000.f); resc=false; mhat=rm; \
    _Pragma("unroll") for(int r=0;r<16;++r)P0[r]=__builtin_amdgcn_exp2f(P0[r]-mhat); }while(0)
  #define RESC() do{ if(resc){ asm volatile("s_waitcnt lgkmcnt(0)":::"memory"); \
      _Pragma("unroll") for(int d_=0;d_<2;++d_) _Pragma("unroll") for(int r=0;r<16;++r)o[d_][r]*=wsf[crow(r,hi)]; } }while(0)
  f32x16 pA0,pA1,pB0,pB1;
  int sl_prev=0,sl_cur=0,sl_next=SLOTB;
  #define ROT() do{sl_prev=sl_cur;sl_cur=sl_next;sl_next=(sl_next==(NSLOT-1)*SLOTB)?0:sl_next+SLOTB;}while(0)
  DMA_K(2,2*SLOTB);
  WAIT_BAR(3);
  qkt(pA0,pA1,Kbase,qr,r32,hi);asm volatile("s_nop 15\n\ts_nop 7":"+v"(pA0),"+v"(pA1));AMASK(pA0,pA1,0);
  START(pA0,pA1);
  _Pragma("unroll") for(int r=0;r<16;++r)pA1[r]=__builtin_amdgcn_exp2f(pA1[r]-mhat);
  WAIT_BAR(0);
  DMA_K(3,0);DMA_V(1,SLOTB);
  ROT();
  kload8(kf,kp0+sl_cur);
  WAIT_BAR(2);
  s16x4 vlo[8],vhi[8]; u32x4 pw0,pw1,pw2,pw3;
  #define PKW(P,B) cvtpk_s(P[B],P[B+1])
  #define PAF(k) __builtin_bit_cast(h16x8,pw##k)
  #define VFR(i) vfr(vlo[i],vhi[i])
  #define PIN(x) asm volatile("":"+v"(x))
  #define MX3(a,b,c) __builtin_fmaxf(__builtin_fmaxf((a),(b)),(c))
  #define GAPA(MF,A0,A1,A2,A3,W0,W1,PW) do{ MF; sacc+=A0; sacc+=A1; sacc+=A2; sacc+=A3; PIN(sacc); W0; W1; PIN(PW); SBAR(); }while(0)
  #define EX(v) __builtin_amdgcn_exp2f(v)
  #define GAPB(MF,X,B) do{ MF; X[B]=EX(X[B]-mhat); X[B+1]=EX(X[B+1]-mhat); X[B+2]=EX(X[B+2]-mhat); X[B+3]=EX(X[B+3]-mhat); PIN(X); SBAR(); }while(0)
  #define VRD(i) do{ vlo[i]=vtr(vp_+(((i)>>2)*4096+((i)&3)*1024)); vhi[i]=vtr(vp_+(((i)>>2)*4096+((i)&3)*1024+512)); }while(0)
  #define KRD(G,j) do{ if(G){ kload2(kf,kp0+sl_next,j); SBAR(); } }while(0)
  #define STEP(C0,C1,P0,P1,t,GK,GV,GL) do{ SBAR(); \
    const lds_cptr vp_=vp0+sl_prev; \
    VRD(0); SBAR(); float sacc=(P0[0]+P0[1]); \
    GAPA(C0=MFMA16(kf[0],qr[0],(f32x16{})), P0[2],P0[3],P0[4],P0[5],     pw0[0]=PKW(P0,0), pw0[1]=PKW(P0,2), pw0); \
    VRD(4); SBAR(); GAPA(C1=MFMA16(kf[1],qr[0],(f32x16{})), P0[6],P0[7],P0[8],P0[9],     pw0[2]=PKW(P0,4), pw0[3]=PKW(P0,6), pw0); \
    VRD(1); SBAR(); GAPA(C0=MFMA16(kf[2],qr[1],C0),   P0[10],P0[11],P0[12],P0[13], pw1[0]=PKW(P0,8), pw1[1]=PKW(P0,10), pw1); \
    VRD(5); SBAR(); GAPA(C1=MFMA16(kf[3],qr[1],C1),   P0[14],P0[15],P1[0],P1[1],   pw1[2]=PKW(P0,12),pw1[3]=PKW(P0,14), pw1); \
    VRD(2); SBAR(); GAPA(C0=MFMA16(kf[4],qr[2],C0),   P1[2],P1[3],P1[4],P1[5],     pw2[0]=PKW(P1,0), pw2[1]=PKW(P1,2), pw2); \
    VRD(6); SBAR(); GAPA(C1=MFMA16(kf[5],qr[2],C1),   P1[6],P1[7],P1[8],P1[9],     pw2[2]=PKW(P1,4), pw2[3]=PKW(P1,6), pw2); \
    VRD(3); SBAR(); GAPA(C0=MFMA16(kf[6],qr[3],C0),   P1[10],P1[11],P1[12],P1[13], pw3[0]=PKW(P1,8), pw3[1]=PKW(P1,10), pw3); \
    VRD(7); SBAR(); GAPA(C1=MFMA16(kf[7],qr[3],C1),   P1[14],P1[15],0.f,0.f,       pw3[2]=PKW(P1,12),pw3[3]=PKW(P1,14), pw3); \
    l_reg+=sacc; \
    if(GK){DMA_K((t)+3,sl_cur);} if(GV){DMA_V((t)+1,sl_next);} \
    AMASK(C0,C1,t); \
    { float a=MX3(C0[0],C0[1],C1[0]),b=MX3(C0[2],C0[3],C1[1]); a=MX3(a,C1[2],C1[3]); \
      _Pragma("unroll") for(int r=4;r<16;r+=4){a=MX3(a,C0[r],C0[r+1]);b=MX3(b,C0[r+2],C0[r+3]);a=MX3(a,C1[r],C1[r+1]);b=MX3(b,C1[r+2],C1[r+3]);} \
      float rm=__builtin_fmaxf(a,b); { auto rr=__builtin_amdgcn_permlane32_swap(__float_as_uint(rm),__float_as_uint(rm),false,false); rm=__builtin_fmaxf(__uint_as_float(rr[0]),__uint_as_float(rr[1])); } \
      rm-=mhat; resc=false; \
      if(__builtin_expect(__any(rm>(float)THRL),0)){ const float dl=__builtin_fmaxf(rm,0.f); mhat+=dl; \
        const float f=__builtin_amdgcn_exp2f(-dl); l_reg*=f; if(hi==0)wsf[r32]=f; resc=true; } } \
    SBAR(); \
    GAPB(o[0]=MFMA16(PAF(0),VFR(0),o[0]), C0,0); \
    GAPB(o[1]=MFMA16(PAF(0),VFR(4),o[1]), C0,4); \
    KRD(GL,0); GAPB(o[0]=MFMA16(PAF(1),VFR(1),o[0]), C0,8); \
    KRD(GL,1); GAPB(o[1]=MFMA16(PAF(1),VFR(5),o[1]), C0,12); \
    KRD(GL,2); GAPB(o[0]=MFMA16(PAF(2),VFR(2),o[0]), C1,0); \
    KRD(GL,3); GAPB(o[1]=MFMA16(PAF(2),VFR(6),o[1]), C1,4); \
    GAPB(o[0]=MFMA16(PAF(3),VFR(3),o[0]), C1,8); \
    GAPB(o[1]=MFMA16(PAF(3),VFR(7),o[1]), C1,12); \
    }while(0)
  int t=1;
  #undef NEARF
  #define NEARF(tt) false
  #define ENDW(tt) do{ if((tt)+3<NT){WAIT_BAR(2);} else if((tt)+2<NT){WAIT_BAR(1);} else {WAIT_BAR(0);} }while(0)
  for(;t+7<NT;t+=2){
    STEP(pB0,pB1,pA0,pA1,t,true,true,true);     WAIT_BAR(2); RESC(); ROT();
    STEP(pA0,pA1,pB0,pB1,t+1,true,true,true);   WAIT_BAR(2); RESC(); ROT();
  }
  #undef NEARF
  #define NEARF(tt) ((tt)>=NT-6)
  for(;t+1<NT;t+=2){
    STEP(pB0,pB1,pA0,pA1,t,(t+3<NT),(t+1<NT),(t+1<NT));       ENDW(t);   RESC(); ROT();
    STEP(pA0,pA1,pB0,pB1,t+1,(t+4<NT),(t+2<NT),(t+2<NT));     ENDW(t+1); RESC(); ROT();
  }
  STEP(pB0,pB1,pA0,pA1,NT-1,false,false,false); RESC();
  #undef NEARF
  { float sacc=pB0[0]+pB0[1]; _Pragma("unroll") for(int r=2;r<16;++r)sacc+=pB0[r]; _Pragma("unroll") for(int r=0;r<16;++r)sacc+=pB1[r]; l_reg+=sacc;
    pw0=(u32x4){PKW(pB0,0),PKW(pB0,2),PKW(pB0,4),PKW(pB0,6)};pw1=(u32x4){PKW(pB0,8),PKW(pB0,10),PKW(pB0,12),PKW(pB0,14)};pw2=(u32x4){PKW(pB1,0),PKW(pB1,2),PKW(pB1,4),PKW(pB1,6)};pw3=(u32x4){PKW(pB1,8),PKW(pB1,10),PKW(pB1,12),PKW(pB1,14)};
    SBAR(); pv(o,vb0+sl_cur,PAF(0),PAF(1),PAF(2),PAF(3)); }
  #undef PKW
  #undef PAF
  #undef VFR
  #undef PIN
  #undef MX3
  #undef GAPA
  #undef GAPB
  #undef EX
  #undef VRD
  #undef KRD
  #undef STEP
  #undef ENDW
  {auto rr=__builtin_amdgcn_permlane32_swap(__float_as_uint(l_reg),__float_as_uint(l_reg),false,false);l_reg=__uint_as_float(rr[0])+__uint_as_float(rr[1]);}
  if(hi==0)wsf[32+r32]=l_reg;asm volatile("s_waitcnt lgkmcnt(0)":::"memory");
  float rli[16];
  #pragma unroll
  for(int r=0;r<16;++r)rli[r]=__builtin_amdgcn_rcpf(wsf[32+crow(r,hi)]);
  { h16*stg=(h16*)(shm+LDS_OST)+wid*2048;
    #pragma unroll
    for(int r=0;r<16;++r){const int orow=crow(r,hi);
      #pragma unroll
      for(int d0=0;d0<2;++d0)stg[orow*64+d0*32+r32]=(h16)(o[d0][r]*rli[r]);}
    asm volatile("s_waitcnt lgkmcnt(0)":::"memory");
    #pragma unroll
    for(int i=0;i<4;++i){const int row=i*8+(lane>>3),ch=lane&7; const h16x8 v=*(const h16x8*)(stg+row*64+ch*8);
      const long grow=rowbase+q0+wid*QBLK+row; const h16x8 z=*(const h16x8*)(AZ+grow*APITCH+h*D+ch*8);
      *(h16x8*)(MIXO+grow*DMIX+1024+h*D+ch*8)=v*z;} }
  asm volatile("s_waitcnt lgkmcnt(0)\n\ts_barrier":::"memory");
  #undef DMA_K
  #undef DMA_V
  #undef AMASK
  #undef START
  #undef RESC
  #undef ROT
}
constexpr int ATTN_LDS_BYTES=LDS_BYTES;
template<int THRL=8> __device__ __forceinline__ void attn_phase(char*lds,const Args&a){
  const int G=gridDim.x, bx=blockIdx.x; const int vcu=(G%8==0)?(bx%8)*(G/8)+bx/8:bx;
  const h16*Q=(const h16*)(a.ws+WS_AQ),*K=(const h16*)(a.ws+WS_AK),*V=(const h16*)(a.ws+WS_AV),*AZ=(const h16*)(a.ws+WS_AZ); h16*MIXO=(h16*)((unsigned char*)a.out+DO_MIX);
  const unsigned long long*MB=(const unsigned long long*)(a.ws+WS_MASKB); const float*BT=(const float*)(a.ws+WS_BT);
  for(int v=vcu;v<256;v+=G){ const int bh=v>>4,s=v&15;
    attn_unit<THRL>(bh>>3,bh&7,s,Q,K,V,AZ,MIXO,MB,BT,lds);
    attn_unit<THRL>(bh>>3,bh&7,31-s,Q,K,V,AZ,MIXO,MB,BT,lds); }
}
#undef SBAR
#undef WAIT_BAR
#undef MFMA16
}

__device__ __forceinline__ void phase_mask_convert(const Args& a) {
    const int lane = threadIdx.x & 63, gw = blockIdx.x * 8 + (threadIdx.x >> 6), NGW = gridDim.x * 8;
    const unsigned* MASK = (const unsigned*)(a.ws + WS_MASK); unsigned long long* MB = (unsigned long long*)(a.ws + WS_MASKB);
    for (int it = gw; it < 2 * 256 * 256; it += NGW) { const int kb = it & 255, qblk = (it >> 8) & 255, b = it >> 16;
        const unsigned w = MASK[(size_t)(b * SEQ + qblk * 32 + (lane & 31)) * 256 + kb];
        unsigned long long mine = 0ull;
#pragma unroll
        for (int r = 0; r < 16; ++r) { const int pos = (r & 3) + 8 * (r >> 2) + 4 * (lane >> 5); const unsigned long long bal = __ballot((w >> pos) & 1u); if (lane == r) mine = bal; }
        if (lane < 16) MB[(size_t)it * 16 + lane] = mine; }
}

constexpr int NPH = 7;
__global__ void __launch_bounds__(512, 2) fwd(Args a) {
    extern __shared__ __attribute__((aligned(16))) unsigned char lds_[];
    LAS unsigned char* lds = (LAS unsigned char*)lds_;
    volatile LAS unsigned* ctlw = (volatile LAS unsigned*)(lds + LDSCTL_OFF);
    const int tid = threadIdx.x;
    if (tid < 64) ctlw[tid] = 0u;
    __syncthreads();
    const int lo = a.ph_lo, hi = a.ph_hi;
    XcdBarrier bar; bar.bar = (unsigned*)(a.ws + WS_CTL) + CW_BAR; bar.x = 0; bar.st = nullptr;
    if (hi - lo > 1) bar = xcd_barrier_post((unsigned*)(a.ws + WS_CTL) + CW_BAR, ctlw + 8);
#define IN(k) (lo <= (k) && (k) < hi)
#define SEAM(k) do { if (IN(k) && IN((k) + 1)) xcd_barrier(bar); } while (0)
    if (IN(0)) phase_prologue(a, lds);
    SEAM(0);
    if (IN(1)) { pg8::Gemm g{(const h16*)(a.ws + WS_XN), (const h16*)(a.ws + WS_WIN), M, NPAD, DM}; pg8::StaticOrder S; S.init(M, NPAD, gridDim.x, blockIdx.x);
        pg8::EpiProj E{a.ws, (unsigned char*)a.out, a.in[3]};
        pg8::gemm_phase<pg8::EpiProj, pg8::StaticOrder, true, true>(lds, g, S, E); }
    SEAM(1);
    if (IN(2)) { if (blockIdx.x < 64) mls::phase_mlstm(a, lds, blockIdx.x);
        idx::phase_index(a, lds); }
    SEAM(2);
    if (IN(3)) { attn_body::attn_phase<8>((char*)lds_, a); phase_headnorm(a, lds); }
    SEAM(3);
    if (IN(4)) {
        { pg8::Gemm g{(const h16*)((unsigned char*)a.out + DO_MIX), (const h16*)(a.ws + WS_WOUT), M, DM, DMIX}; pg8::StaticOrder S; S.init(M, DM, gridDim.x, blockIdx.x);
          pg8::EpiOut E{a.in[0], (float*)(a.ws + WS_H1), (h16*)(a.ws + WS_H1H)};
          pg8::gemm_phase<pg8::EpiOut, pg8::StaticOrder, false, true>(lds, g, S, E); }
        { pg8::Gemm g{(const h16*)(a.ws + WS_P16), (const h16*)(a.ws + WS_WPLE), M, DM, DPLE}; pg8::StaticOrder S; S.init(M, DM, gridDim.x, blockIdx.x);
          pg8::EpiF16 E{(h16*)(a.ws + WS_PB), DM};
          pg8::gemm_phase<pg8::EpiF16, pg8::StaticOrder, false, true>(lds, g, S, E); } }
    SEAM(4);
    if (IN(5)) { pg8::Gemm g{(const h16*)(a.ws + WS_H1H), (const h16*)(a.ws + WS_WGATE), M, DM, DM}; pg8::StaticOrder S; S.init(M, DM, gridDim.x, blockIdx.x);
        pg8::EpiF32 E{a.out, DM};
        pg8::gemm_phase<pg8::EpiF32, pg8::StaticOrder, false, true>(lds, g, S, E); }
    SEAM(5);
    if (IN(6)) phase_tail(a);
#undef IN
#undef SEAM
}
#if DEBUG_CHECKS
__device__ __forceinline__ void flag_err(unsigned* flags, int idx, float ref, float got) {
    const float e = fabsf(ref - got) / (0.03f + 0.02f * fabsf(ref));
    atomicMax(&flags[idx], __float_as_uint(e == e ? e : 1e30f));
}
__global__ void __launch_bounds__(512) k_check_proj(Args a) {
    __shared__ float u[1024]; __shared__ float red[8];
    const int tid = threadIdx.x, lane = tid & 63, wave = tid >> 6; const int r = blockIdx.x;
    unsigned* flags = (unsigned*)(a.ws + WS_FLAGS);
    const float* x = a.in[0] + (size_t)r * DM; const float* g = a.in[6]; const float* W = a.in[2]; const float* bg = a.in[3];
    float s = 0.f; for (int k = tid; k < DM; k += 512) s += x[k] * x[k];
    s = wave_sum(s); if (lane == 0) red[wave] = s; __syncthreads();
    float tot = 0.f; for (int w = 0; w < 8; ++w) tot += red[w];
    const float rstd = 1.0f / sqrtf(tot / DM + EPS);
    for (int k = tid; k < DM; k += 512) u[k] = x[k] * rstd * g[k];
    __syncthreads();
    const h16* MQ = (const h16*)((unsigned char*)a.out + DO_MQ); const h16* MK = (const h16*)((unsigned char*)a.out + DO_MK); const h16* MV = (const h16*)((unsigned char*)a.out + DO_MV);
    const h16* MG = (const h16*)(a.ws + WS_MG); const h16* AQ = (const h16*)(a.ws + WS_AQ); const h16* AK = (const h16*)(a.ws + WS_AK); const h16* AV = (const h16*)(a.ws + WS_AV); const h16* AZ = (const h16*)(a.ws + WS_AZ);
    const h16* IQ = (const h16*)(a.ws + WS_IQ); const h16* IK = (const h16*)(a.ws + WS_IK); const float* IW = (const float*)(a.ws + WS_IW); const float* GT = (const float*)(a.ws + WS_GATES);
    for (int c = tid; c < NPROJ; c += 512) {
        float d = 0.f; for (int k = 0; k < DM; ++k) d += u[k] * W[(size_t)k * NPROJ + c];
        if (c < 512) flag_err(flags, 0, d, (float)MQ[(size_t)r * 512 + c]);
        else if (c < 1024) flag_err(flags, 0, d, (float)MK[(size_t)r * 512 + c - 512]);
        else if (c < 2048) flag_err(flags, 0, d, (float)MV[(size_t)r * 1024 + c - 1024]);
        else if (c < 3072) { float z = 0.f; for (int k = 0; k < DM; ++k) z += u[k] * W[(size_t)k * NPROJ + c + 1024];
            flag_err(flags, 1, sigmoidf_(d) * siluf_(z), (float)MG[(size_t)r * 1024 + c - 2048]); }
        else if (c < 4096) {}
        else if (c < 4100) flag_err(flags, 3, d + bg[c - 4096], GT[(size_t)r * 8 + c - 4096]);
        else if (c < 4104) { const float gg = d + bg[c - 4096]; flag_err(flags, 3, fminf(gg, 0.f) - log1pf(expf(-fabsf(gg))), GT[(size_t)r * 8 + c - 4096]); }
        else if (c < 4616) flag_err(flags, 2, d * C2, (float)AQ[(size_t)r * 512 + c - 4104]);
        else if (c < 5128) flag_err(flags, 2, d, (float)AK[(size_t)r * 512 + c - 4616]);
        else if (c < 5640) flag_err(flags, 2, d, (float)AV[(size_t)r * 512 + c - 5128]);
        else if (c < 6152) flag_err(flags, 2, siluf_(d), (float)AZ[(size_t)r * 512 + c - 5640]);
        else if (c < 6664) flag_err(flags, 3, d * 0.125f, (float)IQ[(size_t)r * 512 + c - 6152]);
        else if (c < 6728) flag_err(flags, 3, d, (float)IK[(size_t)r * 64 + c - 6664]);
        else flag_err(flags, 3, d * 0.35355339059327373f, IW[(size_t)r * 8 + c - 6728]);
    }
}
__global__ void __launch_bounds__(512) k_check_out(Args a) {
    __shared__ float mx[1536]; __shared__ float pr[256]; __shared__ float h1row[1024]; __shared__ float erow[1024];
    const int tid = threadIdx.x; const int i = blockIdx.x; const int r = i * 128 + ((i * 37) & 127);
    unsigned* flags = (unsigned*)(a.ws + WS_FLAGS);
    const h16* MIX = (const h16*)((unsigned char*)a.out) + (size_t)r * DMIX; const float* p = a.in[1] + (size_t)r * DPLE;
    for (int k = tid; k < DMIX; k += 512) mx[k] = (float)MIX[k];
    if (tid < 256) pr[tid] = p[tid];
    __syncthreads();
    const float* Wo = a.in[5]; const float* Wp = a.in[9]; const float* x = a.in[0] + (size_t)r * DM;
    const float* H1 = (const float*)(a.ws + WS_H1) + (size_t)r * DM; const h16* H1H = (const h16*)(a.ws + WS_H1H) + (size_t)r * DM; const h16* PB = (const h16*)(a.ws + WS_PB) + (size_t)r * DM;
    for (int c = tid; c < DM; c += 512) {
        float d = x[c]; for (int k = 0; k < DMIX; ++k) d += mx[k] * Wo[(size_t)k * DM + c];
        flag_err(flags, 4, d, H1[c]); flag_err(flags, 4, d, (float)H1H[c]);
        float e = 0.f; for (int k = 0; k < DPLE; ++k) e += pr[k] * Wp[(size_t)k * DM + c];
        flag_err(flags, 5, e, (float)PB[c]);
        h1row[c] = d; erow[c] = e;
    }
    __syncthreads();
    const float* Wg = a.in[10]; float* DBG = (float*)(a.ws + WS_DBG) + (size_t)i * DM;
    for (int c = tid; c < DM; c += 512) { float gsum = 0.f; for (int k = 0; k < DM; ++k) gsum += h1row[k] * Wg[(size_t)k * DM + c];
        DBG[c] = h1row[c] + erow[c] * sigmoidf_(gsum); }
    if (tid < 64) { float s1 = 0.f, s2 = 0.f; for (int k = tid; k < 1024; k += 64) s1 += mx[k] * mx[k]; for (int k = 1024 + tid; k < 1536; k += 64) s2 += mx[k] * mx[k];
        s1 = wave_sum(s1) / 1024.f; s2 = wave_sum(s2) / 512.f;
        if (tid == 0) { if (!(s1 > 0.02f && s1 < 0.4f)) atomicMax(&flags[7], __float_as_uint(2.0f)); if (!(s2 > 0.0003f && s2 < 0.05f)) atomicMax(&flags[8], __float_as_uint(2.0f)); } }
}
__global__ void __launch_bounds__(512) k_check_h2(Args a) {
    const int tid = threadIdx.x; const int i = blockIdx.x; const int r = i * 128 + ((i * 37) & 127);
    unsigned* flags = (unsigned*)(a.ws + WS_FLAGS);
    const float* H2 = (const float*)(a.ws + WS_H1) + (size_t)r * DM; const float* DBG = (const float*)(a.ws + WS_DBG) + (size_t)i * DM;
    for (int c = tid; c < DM; c += 512) flag_err(flags, 6, DBG[c], H2[c]);
}

__global__ void __launch_bounds__(512) k_check_mlstm(Args a) {
    __shared__ float qt[128]; __shared__ float wgt[SEQ]; __shared__ float red[16]; __shared__ float F[SEQ];
    const int tid = threadIdx.x, lane = tid & 63, wave = tid >> 6;
    const int ti = blockIdx.x & 7;
    const int t = ti == 0 ? 65 : ti == 1 ? 500 : ti == 2 ? 1000 : ti == 3 ? 2047 : ti == 4 ? 2048 : ti == 5 ? 4100 : ti == 6 ? 6000 : 8191, b = (blockIdx.x >> 3) & 1, h = (blockIdx.x >> 3) ? 3 : 0;
    unsigned* flags = (unsigned*)(a.ws + WS_FLAGS);
    const h16* MQ = (const h16*)((unsigned char*)a.out + DO_MQ); const h16* MK = (const h16*)((unsigned char*)a.out + DO_MK); const h16* MV = (const h16*)((unsigned char*)a.out + DO_MV);
    const float* GT = (const float*)(a.ws + WS_GATES); const float* cw = a.in[4]; const float* HR = (const float*)(a.ws + WS_H1);
    if (tid < 128) { float y = 0.f; for (int j = 0; j < 4; ++j) { const int tt = t - 3 + j; if (tt >= 0) y += cw[j * 1024 + h * 128 + tid] * (float)MQ[(size_t)(b * SEQ + tt) * 512 + h * 128 + tid]; } qt[tid] = siluf_(y); }
    if (tid == 0) { float acc = 0.f; for (int s = 0; s <= t; ++s) { acc += GT[(size_t)(b * SEQ + s) * 8 + 4 + h]; F[s] = acc; } }
    __syncthreads();
    const float Ft = F[t];
    __syncthreads();
    float mx = -1e30f;
    for (int s = tid; s <= t; s += 512) { float qk = 0.f;
#pragma unroll 1
        for (int d = 0; d < 128; ++d) { float y = 0.f;
#pragma unroll
            for (int j = 0; j < 4; ++j) { const int tt = s - 3 + j; if (tt >= 0) y += cw[j * 1024 + 512 + h * 128 + d] * (float)MK[(size_t)(b * SEQ + tt) * 512 + h * 128 + d]; }
            qk += qt[d] * siluf_(y) * 0.08838834764831845f; }
        const float Dts = Ft - F[s] + GT[(size_t)(b * SEQ + s) * 8 + h]; mx = fmaxf(mx, Dts); wgt[s] = qk; F[s] = Dts; }
    __syncthreads();
#pragma unroll
    for (int o = 1; o < 64; o <<= 1) mx = fmaxf(mx, __shfl_xor(mx, o));
    if (lane == 0) red[wave] = mx; __syncthreads();
    float mt = Ft; for (int w = 0; w < 8; ++w) mt = fmaxf(mt, red[w]);
    float ds = 0.f;
    for (int s = tid; s <= t; s += 512) { const float wv = wgt[s] * expf(F[s] - mt); wgt[s] = wv; ds += wv; }
    ds = wave_sum(ds); if (lane == 0) red[8 + wave] = ds; __syncthreads();
    float den = 0.f; for (int w = 0; w < 8; ++w) den += red[8 + w];
    den = fmaxf(fabsf(den), expf(-mt));
    if (tid < 256) { float num = 0.f; for (int s = 0; s <= t; ++s) num += wgt[s] * (float)MV[(size_t)(b * SEQ + s) * 1024 + h * 256 + tid];
        flag_err(flags, 9, num / den, HR[(size_t)(b * SEQ + t) * 1024 + h * 256 + tid]); }
}
__global__ void __launch_bounds__(512) k_check_dsa(Args a) {
    __shared__ float sc[SEQ]; __shared__ float qf[512]; __shared__ int sel[256]; __shared__ int nsel; __shared__ float lg[8][256]; __shared__ float hm[8], hs[8];
    const int tid = threadIdx.x; const int ti = blockIdx.x & 7;
    const int t = ti == 0 ? 0 : ti == 1 ? 100 : ti == 2 ? 255 : ti == 3 ? 256 : ti == 4 ? 300 : ti == 5 ? 1000 : ti == 6 ? 5000 : 8191, b = blockIdx.x >> 3, row = b * SEQ + t;
    unsigned* flags = (unsigned*)(a.ws + WS_FLAGS);
    const h16* IQ = (const h16*)(a.ws + WS_IQ); const h16* IK = (const h16*)(a.ws + WS_IK); const float* IW = (const float*)(a.ws + WS_IW);
    const h16* AQ = (const h16*)(a.ws + WS_AQ); const h16* AK = (const h16*)(a.ws + WS_AK); const h16* AV = (const h16*)(a.ws + WS_AV); const h16* AZ = (const h16*)(a.ws + WS_AZ);
    const h16* MIX = (const h16*)((unsigned char*)a.out); const float* rb = a.in[8];
    qf[tid] = (float)IQ[(size_t)row * 512 + tid]; if (tid == 0) nsel = 0;
    __syncthreads();
    for (int s = tid; s <= t; s += 512) { float tot = 0.f;
#pragma unroll 1
        for (int hh = 0; hh < 8; ++hh) { float d = 0.f;
#pragma unroll 4
            for (int j = 0; j < 64; ++j) d += qf[hh * 64 + j] * (float)IK[(size_t)(b * SEQ + s) * 64 + j]; tot += IW[(size_t)row * 8 + hh] * fmaxf(d, 0.f); }
        sc[s] = tot; }
    __syncthreads();
    for (int s = tid; s <= t; s += 512) { const float v = sc[s]; int rank = 0; for (int s2 = 0; s2 <= t; ++s2) { const float v2 = sc[s2]; rank += (v2 > v || (v2 == v && s2 < s)) ? 1 : 0; }
        if (rank < 256) { const int p = atomicAdd(&nsel, 1); sel[p] = s; } }
    __syncthreads();
    const int ns = nsel;
    qf[tid] = (float)AQ[(size_t)row * 512 + tid];
    __syncthreads();
    for (int i = tid; i < 8 * ns; i += 512) { const int hh = i / ns, j = i % ns, s = sel[j]; float d = 0.f;
        for (int k = 0; k < 64; ++k) d += qf[hh * 64 + k] * (float)AK[(size_t)(b * SEQ + s) * 512 + hh * 64 + k];
        lg[hh][j] = d + rb[t5_bucket(t - s) * 8 + hh] * LOG2E; }
    __syncthreads();
    if (tid < 8) { float m = -1e30f; for (int j = 0; j < ns; ++j) m = fmaxf(m, lg[tid][j]); float ssum = 0.f; for (int j = 0; j < ns; ++j) ssum += exp2f(lg[tid][j] - m); hm[tid] = m; hs[tid] = ssum; }
    __syncthreads();
    { const int hh = tid >> 6, d = tid & 63; float o = 0.f; for (int j = 0; j < ns; ++j) o += exp2f(lg[hh][j] - hm[hh]) * (float)AV[(size_t)(b * SEQ + sel[j]) * 512 + hh * 64 + d];
      const float ref = o / hs[hh] * (float)AZ[(size_t)row * 512 + tid];
      const float got = (float)MIX[(size_t)row * DMIX + 1024 + tid];
      const float e = fabsf(ref - got) / (0.003f + 0.02f * fabsf(ref)); atomicMax(&flags[10], __float_as_uint(e == e ? e : 1e30f)); }
}

__global__ void __launch_bounds__(256) k_check_headnorm(Args a) {
    __shared__ float red[4];
    const int tid = threadIdx.x, lane = tid & 63, wave = tid >> 6, row = blockIdx.x >> 2, h = blockIdx.x & 3;
    unsigned* flags = (unsigned*)(a.ws + WS_FLAGS);
    const float* HR = (const float*)(a.ws + WS_H1) + (size_t)row * 1024 + h * 256; const h16* MG = (const h16*)(a.ws + WS_MG) + (size_t)row * 1024 + h * 256;
    const h16* MIX = (const h16*)((unsigned char*)a.out) + (size_t)row * DMIX + h * 256; const float* mn = a.in[7] + h * 256;
    const float v = HR[tid]; float s = wave_sum(v * v); if (lane == 0) red[wave] = s; __syncthreads();
    const float tot = red[0] + red[1] + red[2] + red[3];
    const float ref = v / sqrtf(tot / 256.f + EPS) * mn[tid] * (float)MG[tid];
    const float got = (float)MIX[tid]; const float e = fabsf(ref - got) / (0.003f + 0.01f * fabsf(ref)); atomicMax(&flags[11], __float_as_uint(e == e ? e : 1e30f));
    if (!(e <= 1.0f)) { atomicAdd(&flags[20], 1u); atomicMax(&flags[21], 65535u - (unsigned)blockIdx.x); atomicMax(&flags[22], (unsigned)blockIdx.x); }
}

#endif

extern "C" void kernel_launch(void* const* d_in, const int* in_sizes, int n_in, void* d_out, int out_size, void* d_ws, size_t ws_size, hipStream_t stream) {
    static int ok = 0;
    if (ok == 0) {
        if (n_in != 12 || in_sizes[0] != M * DM || out_size != M * DM || ws_size < WS_END) { fprintf(stderr, "kernel_launch: unexpected shapes (n_in %d, ws %zu)\n", n_in, ws_size); ok = -1; return; }
        if (hipFuncSetAttribute((const void*)fwd, hipFuncAttributeMaxDynamicSharedMemorySize, LDS_BYTES) != hipSuccess) { fprintf(stderr, "kernel_launch: hipFuncSetAttribute failed\n"); ok = -1; return; }
        ok = 1;
    }
    if (ok < 0) return;
    (void)hipMemsetAsync((char*)d_ws + WS_CTL, 0, CTL_ZERO_BYTES, stream);
    Args a{};
    for (int i = 0; i < 12; ++i) a.in[i] = (const float*)d_in[i];
    a.out = (float*)d_out; a.ws = (unsigned char*)d_ws;
#if DEBUG_CHECKS
    for (int ph = 0; ph < NPH; ++ph) { a.ph_lo = ph; a.ph_hi = ph + 1; hipLaunchKernelGGL(fwd, dim3(256), dim3(512), LDS_BYTES, stream, a);
        if (ph == 1) hipLaunchKernelGGL(k_check_proj, dim3(M), dim3(512), 0, stream, a);
        if (ph == 2) hipLaunchKernelGGL(k_check_mlstm, dim3(16), dim3(512), 0, stream, a);
        if (ph == 3) { hipLaunchKernelGGL(k_check_headnorm, dim3(M * 4), dim3(256), 0, stream, a); hipLaunchKernelGGL(k_check_dsa, dim3(16), dim3(512), 0, stream, a); }
        if (ph == 4) hipLaunchKernelGGL(k_check_out, dim3(128), dim3(512), 0, stream, a); }
#else
    a.ph_lo = 0; a.ph_hi = NPH;
    hipLaunchKernelGGL(fwd, dim3(256), dim3(512), LDS_BYTES, stream, a);
#endif
}
```

```cpp
#include <hip/hip_runtime.h>
#include <cstdio>
#include <cstdint>
#ifndef DEBUG_CHECKS
#define DEBUG_CHECKS 0
#endif
#ifndef PROBE_SKIP
#define PROBE_SKIP 0
#endif
#ifndef PROBE_PHASE
#define PROBE_PHASE -1
#endif

constexpr int BATCH = 2, SEQ = 8192, DM = 1024, M = BATCH * SEQ;
constexpr int NPROJ = 6736, NPAD = 6912;
constexpr int DMIX = 1536, DPLE = 256;
constexpr float EPS = 1e-6f;
constexpr float LOG2E = 1.4426950408889634f;
constexpr float C2 = 0.125f * LOG2E;

constexpr size_t MiB = 1u << 20;
constexpr size_t WS_CTL = 0, CTL_ZERO_BYTES = 1 * MiB;
constexpr size_t WS_WIN = 1 * MiB;
constexpr size_t WS_WOUT = 15 * MiB;
constexpr size_t WS_WGATE = 18 * MiB;
constexpr size_t WS_WPLE = 20 * MiB;
constexpr size_t WS_BT = 20 * MiB + 512 * 1024;
constexpr size_t WS_IK = 21 * MiB;
constexpr size_t WS_IW = 23 * MiB;
constexpr size_t WS_GATES = 23 * MiB + 512 * 1024;
constexpr size_t WS_P16 = 24 * MiB;
constexpr size_t WS_XN = 32 * MiB;
constexpr size_t WS_MASKB = 32 * MiB;
constexpr size_t WS_QC = 48 * MiB;
constexpr size_t WS_IQ = 64 * MiB;
constexpr size_t WS_MIX = 32 * MiB;
constexpr size_t WS_AQ = 80 * MiB, WS_AK = 96 * MiB, WS_AV = 112 * MiB, WS_AZ = 128 * MiB;
constexpr size_t WS_H1H = 80 * MiB;
constexpr size_t WS_PB = 112 * MiB;
constexpr size_t WS_MG = 144 * MiB;
constexpr size_t WS_KC = 176 * MiB;
constexpr size_t WS_MASK = 176 * MiB;
constexpr size_t WS_H1 = 192 * MiB;
constexpr size_t WS_END = 256 * MiB;
constexpr size_t WS_DBG = 14 * MiB + 512 * 1024;
constexpr size_t WS_FLAGS = 512 * 1024;
constexpr size_t DO_MQ = 0, DO_MK = 16 * MiB, DO_MV = 32 * MiB;
constexpr size_t DO_MIX = 0;

typedef _Float16 h16;
typedef _Float16 h16x2 __attribute__((ext_vector_type(2)));
typedef _Float16 h16x4 __attribute__((ext_vector_type(4)));
typedef _Float16 h16x8 __attribute__((ext_vector_type(8)));
typedef short s16x8 __attribute__((ext_vector_type(8)));
typedef float f32x4 __attribute__((ext_vector_type(4)));
typedef float f32x2 __attribute__((ext_vector_type(2)));
typedef unsigned u32x4 __attribute__((ext_vector_type(4)));
typedef unsigned u32x2 __attribute__((ext_vector_type(2)));
#define LAS __attribute__((address_space(3)))
#define GAS __attribute__((address_space(1)))

__device__ __forceinline__ unsigned pkh(float lo, float hi) { h16x2 v = {(h16)lo, (h16)hi}; return __builtin_bit_cast(unsigned, v); }
__device__ __forceinline__ float sigmoidf_(float x) { return 1.0f / (1.0f + __expf(-x)); }
__device__ __forceinline__ float siluf_(float x) { return x / (1.0f + __expf(-x)); }
__device__ __forceinline__ float h2f(unsigned short b) { return (float)__builtin_bit_cast(h16, b); }

struct Args { const float* in[12]; float* out; unsigned char* ws; int ph_lo, ph_hi; int skip, pad; };

namespace pg8 {
constexpr int BM = 256, BK = 64, HALF = 128, HTB = HALF * BK * 2, STAGE_BYTES = 8 * HTB, NXCD = 8, WGM = 8;
__host__ __device__ __forceinline__ int lds_byte(int r, int c) { const int st = (r >> 4) * 2 + (c >> 5), rr = r & 15, cc = c & 31, ob = rr * 64 + cc * 2; return st * 1024 + (ob ^ (((ob >> 9) & 1) << 5)); }
__host__ __device__ __forceinline__ void stage_rc(int b, int& R, int& C) { const int st = b / 1024, sb = b % 1024, swz = sb ^ (((sb >> 9) & 1) << 5); R = (st >> 1) * 16 + swz / 64; C = (st & 1) * 32 + (swz % 64) / 2; }
__host__ __device__ __forceinline__ int perm32(int rho) { const int n = rho >> 4, i = rho & 15; return 8 * (i >> 2) + 4 * n + (i & 3); }

struct Unit { int pm, pn; };
struct Gemm { const h16* A; const h16* Bt; int M, N, K; };

struct StaticOrder {
    int nM, nN, nwg, G, c;
    __host__ __device__ void init(int M_, int N_, int G_, int c_) { nM = M_ / BM; nN = N_ / BM; nwg = nM * nN; G = G_; c = c_; }
    __host__ __device__ bool next(int i, Unit& u) const {
        const long L = (long)i * G + c; if (L >= nwg) return false;
        int wgid = (int)L; { const int q = nwg / NXCD, r = nwg % NXCD, xcd = wgid % NXCD, off = wgid / NXCD; wgid = (xcd < r ? xcd * (q + 1) : r * (q + 1) + (xcd - r) * q) + off; }
        const int nig = WGM * nN, gid = wgid / nig, fm = gid * WGM, gsz = (nM - fm) < WGM ? (nM - fm) : WGM;
        u.pm = fm + ((wgid % nig) % gsz); u.pn = (wgid % nig) / gsz; return true;
    }
};

template <class Epi, class Sched, bool ALIGN_EPI = false, bool SP2 = false>
__device__ __forceinline__ void gemm_phase(LAS unsigned char* lds, const Gemm g, const Sched& S, const Epi& E) {
    const int tid = threadIdx.x, wid = __builtin_amdgcn_readfirstlane(tid >> 6), lane = tid & 63, wr = wid >> 2, wc = wid & 3, fr = lane & 15, fq = lane >> 4;
    const int K = g.K, nt = K / BK;
    unsigned voffA[2], voffB[2];
#pragma unroll
    for (int i = 0; i < 2; ++i) { int R, C; stage_rc(tid * 16 + i * 8192, R, C); const int Rb = Epi::PERM ? ((R & ~31) + perm32(R & 31)) : R;
        voffA[i] = (unsigned)(R * K + C) * 2u; voffB[i] = (unsigned)(Rb * K + C) * 2u; }
    const size_t kstep = (size_t)(BK * 2);
    const size_t hstep = (size_t)HALF * K * 2;
    const size_t tstep = 2 * hstep;
    const unsigned ldsw = (unsigned)wid * 1024u;
    const int aoff = lds_byte(wr * 64 + fr, fq * 8), boff = lds_byte(wc * 32 + fr, fq * 8);
#define PG8_SA(b, h) (((b) * 2 + (h)) * HTB)
#define PG8_SB(b, h) ((4 + (b) * 2 + (h)) * HTB)
#define PG8_STAGE(bufoff, gbase, voff) do { _Pragma("unroll") for (int _i = 0; _i < 2; ++_i) \
        __builtin_amdgcn_global_load_lds((const unsigned*)((const char*)(gbase) + (voff)[_i]), (LAS unsigned*)(lds + (bufoff) + ldsw + _i * 8192), 16, 0, 0); } while (0)
#define PG8_LDA(dst, b, h) do { _Pragma("unroll") for (int m = 0; m < 4; ++m) _Pragma("unroll") for (int k = 0; k < 2; ++k) dst[m][k] = *(const LAS h16x8*)(lds + PG8_SA(b, h) + aoff + m * 2048 + k * 1024); } while (0)
#define PG8_LDB(dst, b, h) do { _Pragma("unroll") for (int n = 0; n < 2; ++n) _Pragma("unroll") for (int k = 0; k < 2; ++k) dst[n][k] = *(const LAS h16x8*)(lds + PG8_SB(b, h) + boff + n * 2048 + k * 1024); } while (0)
#define PG8_MMA(ai, bj, At, Bt) do { __builtin_amdgcn_s_setprio(1); _Pragma("unroll") for (int m = 0; m < 4; ++m) _Pragma("unroll") for (int n = 0; n < 2; ++n) _Pragma("unroll") for (int k = 0; k < 2; ++k) \
        acc[ai][bj][m][n] = __builtin_amdgcn_mfma_f32_16x16x32_f16(Bt[n][k], At[m][k], acc[ai][bj][m][n], 0, 0, 0); __builtin_amdgcn_s_setprio(0); } while (0)
#define PG8_WAIT_V(n) asm volatile("s_waitcnt vmcnt(" #n ")" ::: "memory")
#define PG8_WAIT_L(n) asm volatile("s_waitcnt lgkmcnt(" #n ")" ::: "memory")
#define PG8_BAR __builtin_amdgcn_s_barrier()
#define PG8_SCHED __builtin_amdgcn_sched_barrier(0)
    Unit cur, nxt; int ui = 0;
    if (!S.next(0, cur)) return;
    f32x4 acc[2][2][4][2];
#pragma unroll
    for (int a = 0; a < 2; ++a)
#pragma unroll
        for (int b = 0; b < 2; ++b)
#pragma unroll
            for (int m = 0; m < 4; ++m)
#pragma unroll
                for (int n = 0; n < 2; ++n) acc[a][b][m][n] = (f32x4){0.f, 0.f, 0.f, 0.f};
    h16x8 At[4][2], B0[2][2], B1[2][2];
    const char* cA = (const char*)g.A + (size_t)cur.pm * tstep; const char* cB = (const char*)g.Bt + (size_t)cur.pn * tstep;
    if constexpr (SP2) {
        PG8_STAGE(PG8_SB(0, 0), cB, voffB); PG8_STAGE(PG8_SB(0, 1), cB + hstep, voffB); PG8_STAGE(PG8_SA(0, 0), cA, voffA); PG8_STAGE(PG8_SA(0, 1), cA + hstep, voffA);
        if (wr == 1) PG8_BAR;
        PG8_WAIT_V(2); PG8_BAR;
        PG8_STAGE(PG8_SB(1, 0), cB + kstep, voffB); PG8_STAGE(PG8_SA(1, 0), cA + kstep, voffA); PG8_STAGE(PG8_SB(1, 1), cB + hstep + kstep, voffB);
        PG8_WAIT_V(6); PG8_BAR;
    } else {
        PG8_STAGE(PG8_SB(0, 0), cB, voffB); PG8_STAGE(PG8_SA(0, 0), cA, voffA); PG8_STAGE(PG8_SB(0, 1), cB + hstep, voffB); PG8_STAGE(PG8_SA(0, 1), cA + hstep, voffA);
        if (wr == 1) PG8_BAR;
        PG8_WAIT_V(4); PG8_BAR;
        PG8_STAGE(PG8_SB(1, 0), cB + kstep, voffB); PG8_STAGE(PG8_SA(1, 0), cA + kstep, voffA); PG8_STAGE(PG8_SB(1, 1), cB + hstep + kstep, voffB);
        PG8_WAIT_V(6); PG8_BAR;
    }
    for (;;) {
        const bool has_next = S.next(ui + 1, nxt);
        const char* nA = has_next ? (const char*)g.A + (size_t)nxt.pm * tstep : cA; const char* nB = has_next ? (const char*)g.Bt + (size_t)nxt.pn * tstep : cB;
        for (int t = 0; t < nt; t += 2) {
            const bool last = (t == nt - 2);
            const char* a1 = cA + (size_t)(t + 1) * kstep;
            const char* a2 = last ? nA : cA + (size_t)(t + 2) * kstep; const char* b2 = last ? nB : cB + (size_t)(t + 2) * kstep;
            const char* a3 = a2 + kstep; const char* b3 = b2 + kstep;
            if constexpr (SP2) {
            PG8_LDB(B0, 0, 0); PG8_LDB(B1, 0, 1); PG8_SCHED; PG8_LDA(At, 0, 0); PG8_STAGE(PG8_SA(1, 1), a1 + hstep, voffA);
            PG8_WAIT_V(8); PG8_WAIT_L(0); PG8_BAR; PG8_MMA(0, 0, At, B0); PG8_MMA(0, 1, At, B1); PG8_BAR; PG8_SCHED;
            PG8_LDA(At, 0, 1); PG8_STAGE(PG8_SB(0, 0), b2, voffB); PG8_STAGE(PG8_SB(0, 1), b2 + hstep, voffB); PG8_STAGE(PG8_SA(0, 0), a2, voffA);
            PG8_WAIT_V(8); PG8_WAIT_L(0); PG8_BAR; PG8_MMA(1, 0, At, B0); PG8_MMA(1, 1, At, B1); PG8_BAR; PG8_SCHED;
            PG8_LDB(B0, 1, 0); PG8_LDB(B1, 1, 1); PG8_SCHED; PG8_LDA(At, 1, 0); PG8_STAGE(PG8_SA(0, 1), a2 + hstep, voffA);
            PG8_WAIT_V(8); PG8_WAIT_L(0); PG8_BAR; PG8_MMA(0, 0, At, B0); PG8_MMA(0, 1, At, B1); PG8_BAR; PG8_SCHED;
            PG8_LDA(At, 1, 1); PG8_STAGE(PG8_SB(1, 0), b3, voffB); PG8_STAGE(PG8_SB(1, 1), b3 + hstep, voffB); PG8_STAGE(PG8_SA(1, 0), a3, voffA);
            PG8_WAIT_V(8); PG8_WAIT_L(0); PG8_BAR; PG8_MMA(1, 0, At, B0); PG8_MMA(1, 1, At, B1); PG8_BAR; PG8_SCHED;
            } else {
            PG8_LDB(B0, 0, 0); PG8_SCHED; PG8_LDA(At, 0, 0); PG8_STAGE(PG8_SA(1, 1), a1 + hstep, voffA);
            PG8_WAIT_L(8); PG8_BAR; PG8_WAIT_L(0); PG8_MMA(0, 0, At, B0); PG8_BAR; PG8_SCHED;
            PG8_LDB(B1, 0, 1); PG8_STAGE(PG8_SB(0, 0), b2, voffB);
            PG8_BAR; PG8_WAIT_L(0); PG8_MMA(0, 1, At, B1); PG8_BAR;
            PG8_LDA(At, 0, 1); PG8_STAGE(PG8_SA(0, 0), a2, voffA);
            PG8_BAR; PG8_WAIT_L(0); PG8_MMA(1, 0, At, B0); PG8_BAR; PG8_SCHED;
            PG8_STAGE(PG8_SB(0, 1), b2 + hstep, voffB);
            PG8_WAIT_V(6); PG8_BAR; PG8_MMA(1, 1, At, B1); PG8_BAR;
            PG8_LDB(B0, 1, 0); PG8_SCHED; PG8_LDA(At, 1, 0); PG8_STAGE(PG8_SA(0, 1), a2 + hstep, voffA);
            PG8_WAIT_L(8); PG8_BAR; PG8_WAIT_L(0); PG8_MMA(0, 0, At, B0); PG8_BAR; PG8_SCHED;
            PG8_LDB(B1, 1, 1); PG8_STAGE(PG8_SB(1, 0), b3, voffB);
            PG8_BAR; PG8_WAIT_L(0); PG8_MMA(0, 1, At, B1); PG8_BAR;
            PG8_LDA(At, 1, 1); PG8_STAGE(PG8_SA(1, 0), a3, voffA);
            PG8_BAR; PG8_WAIT_L(0); PG8_MMA(1, 0, At, B0); PG8_BAR; PG8_SCHED;
            PG8_STAGE(PG8_SB(1, 1), b3 + hstep, voffB);
            PG8_WAIT_V(6); PG8_BAR; PG8_MMA(1, 1, At, B1); PG8_BAR;
            }
        }
        if constexpr (ALIGN_EPI) { if (wr == 0) PG8_BAR; }
        E(acc, cur, wr, wc, fr, fq);
        if (!has_next) break;
#pragma unroll
        for (int a = 0; a < 2; ++a)
#pragma unroll
            for (int b = 0; b < 2; ++b)
#pragma unroll
                for (int m = 0; m < 4; ++m)
#pragma unroll
                    for (int n = 0; n < 2; ++n) acc[a][b][m][n] = (f32x4){0.f, 0.f, 0.f, 0.f};
        cur = nxt; cA = nA; cB = nB; ++ui;
        if constexpr (ALIGN_EPI) { if (wr == 1) PG8_BAR; }
    }
    PG8_WAIT_V(0);
    if constexpr (!ALIGN_EPI) { if (wr == 0) PG8_BAR; }
    PG8_BAR;
#undef PG8_SA
#undef PG8_SB
#undef PG8_STAGE
#undef PG8_LDA
#undef PG8_LDB
#undef PG8_MMA
#undef PG8_WAIT_V
#undef PG8_WAIT_L
#undef PG8_BAR
#undef PG8_SCHED
}

struct EpiProj {
    static constexpr bool PERM = true;
    unsigned char* ws; unsigned char* dout; const float* b_gate;
    __device__ __forceinline__ void operator()(const f32x4 (&acc)[2][2][4][2], const Unit& u, int wr, int wc, int fr, int fq) const {
        const int pn = u.pn; const int row0 = u.pm * BM + wr * 64 + fr; const int cw = wc * 32 + 8 * fq;
        if (pn >= 8 && pn < 16) {
            h16* base = (h16*)(ws + WS_MG) + (pn - 8) * 128 + cw;
#pragma unroll
            for (int ai = 0; ai < 2; ++ai)
#pragma unroll
                for (int m = 0; m < 4; ++m) { const f32x4 o0 = acc[ai][0][m][0], o1 = acc[ai][0][m][1], z0 = acc[ai][1][m][0], z1 = acc[ai][1][m][1];
                    float r[8];
#pragma unroll
                    for (int j = 0; j < 4; ++j) { r[j] = sigmoidf_(o0[j]) * siluf_(z0[j]); r[4 + j] = sigmoidf_(o1[j]) * siluf_(z1[j]); }
                    u32x4 w; w.x = pkh(r[0], r[1]); w.y = pkh(r[2], r[3]); w.z = pkh(r[4], r[5]); w.w = pkh(r[6], r[7]);
                    *(u32x4*)(base + (size_t)(row0 + ai * HALF + m * 16) * 1024) = w; }
            return;
        }
        if (pn == 26) {
            if (wc < 2) { h16* base = (h16*)(ws + WS_IK) + cw;
#pragma unroll
                for (int ai = 0; ai < 2; ++ai)
#pragma unroll
                    for (int m = 0; m < 4; ++m) { const f32x4 v0 = acc[ai][0][m][0], v1 = acc[ai][0][m][1];
                        u32x4 w; w.x = pkh(v0[0], v0[1]); w.y = pkh(v0[2], v0[3]); w.z = pkh(v1[0], v1[1]); w.w = pkh(v1[2], v1[3]);
                        *(u32x4*)(base + (size_t)(row0 + ai * HALF + m * 16) * 64) = w; }
            } else if (wc == 2 && fq == 0) { float* base = (float*)(ws + WS_IW); const float sc = 0.35355339059327373f;
#pragma unroll
                for (int ai = 0; ai < 2; ++ai)
#pragma unroll
                    for (int m = 0; m < 4; ++m) { float* p = base + (size_t)(row0 + ai * HALF + m * 16) * 8; *(f32x4*)p = acc[ai][0][m][0] * sc; *(f32x4*)(p + 4) = acc[ai][0][m][1] * sc; }
            } else if (wc == 2 && fq == 1) { float* base = (float*)(ws + WS_GATES); const f32x4 bi = *(const f32x4*)b_gate, bf = *(const f32x4*)(b_gate + 4);
#pragma unroll
                for (int ai = 0; ai < 2; ++ai)
#pragma unroll
                    for (int m = 0; m < 4; ++m) { float* p = base + (size_t)(row0 + ai * HALF + m * 16) * 8; *(f32x4*)p = acc[ai][0][m][0] + bi;
                        const f32x4 g = acc[ai][0][m][1] + bf; f32x4 lf;
#pragma unroll
                        for (int j = 0; j < 4; ++j) lf[j] = fminf(g[j], 0.f) - log1pf(expf(-fabsf(g[j])));
                        *(f32x4*)(p + 4) = lf; }
            }
            return;
        }
        h16* base; int pitch; int coff; float sc = 1.f; bool act = false;
        if (pn < 2)       { base = (h16*)(dout + DO_MQ); pitch = 512;  coff = pn * 256; }
        else if (pn < 4)  { base = (h16*)(dout + DO_MK); pitch = 512;  coff = (pn - 2) * 256; }
        else if (pn < 8)  { base = (h16*)(dout + DO_MV); pitch = 1024; coff = (pn - 4) * 256; }
        else if (pn < 18) { base = (h16*)(ws + WS_AQ);   pitch = 512;  coff = (pn - 16) * 256; sc = C2; }
        else if (pn < 20) { base = (h16*)(ws + WS_AK);   pitch = 512;  coff = (pn - 18) * 256; }
        else if (pn < 22) { base = (h16*)(ws + WS_AV);   pitch = 512;  coff = (pn - 20) * 256; }
        else if (pn < 24) { base = (h16*)(ws + WS_AZ);   pitch = 512;  coff = (pn - 22) * 256; act = true; }
        else              { base = (h16*)(ws + WS_IQ);   pitch = 512;  coff = (pn - 24) * 256; sc = 0.125f; }
#pragma unroll
        for (int ai = 0; ai < 2; ++ai)
#pragma unroll
            for (int m = 0; m < 4; ++m) { h16* rowp = base + (size_t)(row0 + ai * HALF + m * 16) * pitch + coff + cw;
#pragma unroll
                for (int bj = 0; bj < 2; ++bj) { f32x4 v0 = acc[ai][bj][m][0], v1 = acc[ai][bj][m][1];
                    if (act) {
#pragma unroll
                        for (int j = 0; j < 4; ++j) { v0[j] = siluf_(v0[j]); v1[j] = siluf_(v1[j]); } }
                    v0 = v0 * sc; v1 = v1 * sc;
                    u32x4 w; w.x = pkh(v0[0], v0[1]); w.y = pkh(v0[2], v0[3]); w.z = pkh(v1[0], v1[1]); w.w = pkh(v1[2], v1[3]);
                    *(u32x4*)(rowp + bj * HALF) = w; } }
    }
};
struct EpiF16 {
    static constexpr bool PERM = true;
    h16* O; int ldc;
    __device__ __forceinline__ void operator()(const f32x4 (&acc)[2][2][4][2], const Unit& u, int wr, int wc, int fr, int fq) const {
        const int row0 = u.pm * BM + wr * 64 + fr; const int col0 = u.pn * BM + wc * 32 + 8 * fq;
#pragma unroll
        for (int ai = 0; ai < 2; ++ai)
#pragma unroll
            for (int m = 0; m < 4; ++m) { h16* rowp = O + (size_t)(row0 + ai * HALF + m * 16) * ldc + col0;
#pragma unroll
                for (int bj = 0; bj < 2; ++bj) { const f32x4 v0 = acc[ai][bj][m][0], v1 = acc[ai][bj][m][1];
                    u32x4 w; w.x = pkh(v0[0], v0[1]); w.y = pkh(v0[2], v0[3]); w.z = pkh(v1[0], v1[1]); w.w = pkh(v1[2], v1[3]);
                    *(u32x4*)(rowp + bj * HALF) = w; } }
    }
};
struct EpiOut {
    static constexpr bool PERM = false;
    const float* x; float* h1; h16* h1h;
    __device__ __forceinline__ void operator()(const f32x4 (&acc)[2][2][4][2], const Unit& u, int wr, int wc, int fr, int fq) const {
        const int row0 = u.pm * BM + wr * 64 + fr; const int col0 = u.pn * BM + wc * 32 + 4 * fq;
#pragma unroll
        for (int ai = 0; ai < 2; ++ai)
#pragma unroll
            for (int m = 0; m < 4; ++m) { const size_t off = (size_t)(row0 + ai * HALF + m * 16) * DM + col0;
#pragma unroll
                for (int bj = 0; bj < 2; ++bj)
#pragma unroll
                    for (int n = 0; n < 2; ++n) { const size_t o = off + bj * HALF + n * 16; const f32x4 v = *(const f32x4*)(x + o) + acc[ai][bj][m][n];
                        *(f32x4*)(h1 + o) = v; u32x2 w; w.x = pkh(v[0], v[1]); w.y = pkh(v[2], v[3]); *(u32x2*)(h1h + o) = w; } }
    }
};
struct EpiF32 {
    static constexpr bool PERM = false;
    float* O; int ldc;
    __device__ __forceinline__ void operator()(const f32x4 (&acc)[2][2][4][2], const Unit& u, int wr, int wc, int fr, int fq) const {
        const int row0 = u.pm * BM + wr * 64 + fr; const int col0 = u.pn * BM + wc * 32 + 4 * fq;
#pragma unroll
        for (int ai = 0; ai < 2; ++ai)
#pragma unroll
            for (int m = 0; m < 4; ++m) { const size_t off = (size_t)(row0 + ai * HALF + m * 16) * ldc + col0;
#pragma unroll
                for (int bj = 0; bj < 2; ++bj)
#pragma unroll
                    for (int n = 0; n < 2; ++n) *(f32x4*)(O + off + bj * HALF + n * 16) = acc[ai][bj][m][n]; }
    }
};
}

__device__ __forceinline__ float wave_sum(float v) {
#pragma unroll
    for (int o = 1; o < 64; o <<= 1) v += __shfl_xor(v, o);
    return v;
}
__device__ __forceinline__ int win_map(int n) {
    if (n < 2048) return n;
    if (n < 3072) { const int j = n - 2048; return 2048 + (j >> 7) * 256 + (j & 127); }
    if (n < 4096) { const int j = n - 3072; return 2048 + (j >> 7) * 256 + 128 + (j & 127); }
    if (n < 4104) return 6728 + (n - 4096);
    if (n < 6664) return 4096 + (n - 4104);
    if (n < 6728) return 6656 + (n - 6664);
    return 6720 + (n - 6728);
}
template <bool MAP>
__device__ __forceinline__ void p0_transpose_item(const float* W, int K, int N, h16* WT, LAS float* scr, int item, int lane) {
    const int nblk = (N + 31) / 32, kb = item / nblk, nb = item % nblk, k0 = 64 * kb, n0 = 32 * nb;
    const int ncol = n0 + (lane & 31);
#pragma unroll 8
    for (int i = 0; i < 32; ++i) { const int kk = 2 * i + (lane >> 5); scr[kk * 33 + (lane & 31)] = (ncol < N) ? W[(size_t)(k0 + kk) * N + ncol] : 0.f; }
    asm volatile("s_waitcnt lgkmcnt(0)" ::: "memory");
    const int c = lane & 7;
#pragma unroll
    for (int j = 0; j < 4; ++j) { const int n = (lane >> 3) + 8 * j; const LAS float* s = scr + (8 * c) * 33 + n;
        u32x4 o; o.x = pkh(s[0 * 33], s[1 * 33]); o.y = pkh(s[2 * 33], s[3 * 33]); o.z = pkh(s[4 * 33], s[5 * 33]); o.w = pkh(s[6 * 33], s[7 * 33]);
        if (n0 + n < N) { const int row = MAP ? win_map(n0 + n) : (n0 + n); *(u32x4*)(WT + (size_t)row * K + k0 + 8 * c) = o; } }
    asm volatile("s_waitcnt lgkmcnt(0)" ::: "memory");
}
__device__ __forceinline__ int t5_bucket(int dist) {
    if (dist < 16) return dist;
    const int large = 16 + (int)(logf((float)dist * (1.0f / 16.0f)) / logf(8.0f) * 16.0f);
    return large < 31 ? large : 31;
}

#define XB_TMO      128
#define XB_XCNT(j)  (256  + 64 * (j))
#define XB_XSUB(j)  (1280 + 64 * (j))
#define XB_XGEN(j)  (2304 + 64 * (j))
#define XB_TOP      3328
#define XB_TOPGEN   3392
#define XCD_BAR_WORDS 3456
#define XB_SPIN_CAP (1u << 18)
__device__ __forceinline__ unsigned xb_ld(unsigned* p)              { return __hip_atomic_load(p, __ATOMIC_RELAXED, __HIP_MEMORY_SCOPE_AGENT); }
__device__ __forceinline__ unsigned xb_add(unsigned* p, unsigned v) { return __hip_atomic_fetch_add(p, v, __ATOMIC_RELAXED, __HIP_MEMORY_SCOPE_AGENT); }
__device__ __forceinline__ unsigned xb_xcc_id() { return (unsigned)__builtin_amdgcn_s_getreg((3 << 11) | 20) & 0xFu; }
#define XB_SPIN(cond, bar) do { unsigned _sp = 0; while (cond) { __builtin_amdgcn_s_sleep(1); \
    if ((++_sp & 255u) == 0u) { if (xb_ld(&(bar)[XB_TMO])) break; if (_sp > XB_SPIN_CAP) { atomicAdd(&(bar)[XB_TMO], 1u); break; } } } } while (0)
struct XcdBarrier { unsigned* bar; unsigned x; volatile LAS unsigned* st; };
__device__ __forceinline__ XcdBarrier xcd_barrier_post(unsigned* bar, volatile LAS unsigned* st) {
    XcdBarrier b; b.bar = bar; b.x = xb_xcc_id(); b.st = st;
    if (threadIdx.x == 0) (void)xb_add(&bar[XB_XCNT(b.x)], 1u);
    return b;
}
__device__ __forceinline__ void xcd_barrier_complete(unsigned* bar, unsigned x, unsigned& nloc, unsigned& nx) {
    const unsigned G = gridDim.x * gridDim.y * gridDim.z;
    unsigned sum, cnt, mine, sp = 0u;
    for (;;) {
        sum = 0u; cnt = 0u; mine = 0u;
#pragma unroll
        for (unsigned j = 0; j < 16; ++j) { const unsigned c = xb_ld(&bar[XB_XCNT(j)]); sum += c; cnt += (c > 0u) ? 1u : 0u; mine = (j == x) ? c : mine; }
        if (sum == G) break;
        __builtin_amdgcn_s_sleep(1);
        if ((++sp & 255u) == 0u) { if (xb_ld(&bar[XB_TMO])) break; if (sp > XB_SPIN_CAP) { atomicAdd(&bar[XB_TMO], 1u); break; } }
    }
    nloc = mine > 0u ? mine : 1u; nx = cnt > 0u ? cnt : 1u;
}
__device__ __forceinline__ void xcd_barrier(const XcdBarrier& b) {
    asm volatile("s_waitcnt vmcnt(0)" ::: "memory");
    __syncthreads();
    if (threadIdx.x == 0) {
        unsigned* bar = b.bar;
        __builtin_amdgcn_s_waitcnt(0);
        unsigned nloc = b.st[0], nx = b.st[1];
        if (nloc == 0u) { xcd_barrier_complete(bar, b.x, nloc, nx); b.st[0] = nloc; b.st[1] = nx; }
        const unsigned old = xb_add(&bar[XB_XSUB(b.x)], 1u);
        const unsigned gen = old / nloc;
        if (old + 1u == (gen + 1u) * nloc) {
            __builtin_amdgcn_fence(__ATOMIC_RELEASE, "agent");
            asm volatile("s_waitcnt vmcnt(0)" ::: "memory");
            const unsigned og = xb_add(&bar[XB_TOP], 1u);
            const unsigned tg = og / nx;
            if (og + 1u == (tg + 1u) * nx) xb_add(&bar[XB_TOPGEN], 1u);
            else XB_SPIN(xb_ld(&bar[XB_TOPGEN]) == tg, bar);
            __builtin_amdgcn_fence(__ATOMIC_ACQUIRE, "agent");
            xb_add(&bar[XB_XGEN(b.x)], 1u);
            asm volatile("s_waitcnt vmcnt(0)" ::: "memory");
        } else {
            XB_SPIN(xb_ld(&bar[XB_XGEN(b.x)]) == gen, bar);
            __builtin_amdgcn_fence(__ATOMIC_ACQUIRE, "agent");
            asm volatile("s_waitcnt vmcnt(0)" ::: "memory");
        }
    }
    __syncthreads();
}

constexpr int RING_BYTES = 131072, LDSCTL_OFF = RING_BYTES, LDS_BYTES = 147456;
constexpr int CW_BAR = 4096;

__device__ __forceinline__ void phase_prologue(const Args& a, LAS unsigned char* lds) {
    const int tid = threadIdx.x, lane = tid & 63, wave = tid >> 6;
    LAS float* scr = (LAS float*)(lds + wave * 16384);
    const int gw = blockIdx.x * 8 + wave, NGW = gridDim.x * 8;
    const float* w_in = a.in[2]; const float* w_out = a.in[5]; const float* w_ple = a.in[9]; const float* w_gate = a.in[10];
    h16* WIN = (h16*)(a.ws + WS_WIN); h16* WOUT = (h16*)(a.ws + WS_WOUT); h16* WGATE = (h16*)(a.ws + WS_WGATE); h16* WPLE = (h16*)(a.ws + WS_WPLE);
    constexpr int I_IN = (DM / 64) * ((NPROJ + 31) / 32), I_OUT = (DMIX / 64) * (DM / 32), I_G = (DM / 64) * (DM / 32), I_P = (DPLE / 64) * (DM / 32);
    constexpr int NITEMS = I_IN + I_OUT + I_G + I_P;
    for (int it = gw; it < NITEMS; it += NGW) {
        int r = it;
        if (r < I_IN) { p0_transpose_item<true>(w_in, DM, NPROJ, WIN, scr, r, lane); continue; } r -= I_IN;
        if (r < I_OUT) { p0_transpose_item<false>(w_out, DMIX, DM, WOUT, scr, r, lane); continue; } r -= I_OUT;
        if (r < I_G) { p0_transpose_item<false>(w_gate, DM, DM, WGATE, scr, r, lane); continue; } r -= I_G;
        p0_transpose_item<false>(w_ple, DPLE, DM, WPLE, scr, r, lane);
    }
    for (int r = gw; r < NPAD - NPROJ; r += NGW) { u32x4* p = (u32x4*)(WIN + (size_t)(NPROJ + r) * DM) + lane; p[0] = (u32x4){0, 0, 0, 0}; p[64] = (u32x4){0, 0, 0, 0}; }
    const float* x = a.in[0]; const float* p = a.in[1]; const float* g_in = a.in[6];
    h16* XN = (h16*)(a.ws + WS_XN); h16* P16 = (h16*)(a.ws + WS_P16);
    f32x4 gv[4];
#pragma unroll
    for (int j = 0; j < 4; ++j) gv[j] = ((const f32x4*)g_in)[lane + 64 * j];
    for (int m = gw; m < M; m += NGW) {
        const f32x4* xr = (const f32x4*)(x + (size_t)m * DM) + lane; f32x4 v[4]; float s = 0.f;
#pragma unroll
        for (int j = 0; j < 4; ++j) { v[j] = xr[64 * j]; s += (v[j].x * v[j].x + v[j].y * v[j].y) + (v[j].z * v[j].z + v[j].w * v[j].w); }
        const float rstd = 1.0f / sqrtf(wave_sum(s) * (1.0f / DM) + EPS);
        u32x2* o8 = (u32x2*)(XN + (size_t)m * DM) + lane;
#pragma unroll
        for (int j = 0; j < 4; ++j) { u32x2 w; w.x = pkh(v[j].x * rstd * gv[j].x, v[j].y * rstd * gv[j].y); w.y = pkh(v[j].z * rstd * gv[j].z, v[j].w * rstd * gv[j].w); o8[64 * j] = w; }
        const f32x4 pv = ((const f32x4*)(p + (size_t)m * DPLE))[lane]; u32x2 w; w.x = pkh(pv.x, pv.y); w.y = pkh(pv.z, pv.w);
        ((u32x2*)(P16 + (size_t)m * DPLE))[lane] = w;
    }
    if (blockIdx.x == 0) { const float* rb = a.in[8]; float* BT = (float*)(a.ws + WS_BT);
        for (int i = tid; i < 128 * 8; i += 512) { const int d = i >> 3, h = i & 7; BT[i] = (rb[t5_bucket(d) * 8 + h] - rb[31 * 8 + h]) * LOG2E; } }
}

__device__ __forceinline__ void phase_mlstm_naive(const Args& a, LAS unsigned char* lds, int blk) {
    LAS float* qs = (LAS float*)lds; LAS float* ks = (LAS float*)(lds + 32768); LAS float* vs = (LAS float*)(lds + 65536); LAS float* lis = (LAS float*)(lds + 73728); LAS float* lfs = (LAS float*)(lds + 73984);
    const int tid = threadIdx.x, lane = tid & 63, w = tid >> 6, vq = lane >> 4, dg = lane & 15, vv = 4 * w + vq;
    const int bh = blk >> 3, slice = blk & 7, b = bh >> 2, h = bh & 3;
    const h16* MQ = (const h16*)((unsigned char*)a.out + DO_MQ); const h16* MK = (const h16*)((unsigned char*)a.out + DO_MK); const h16* MV = (const h16*)((unsigned char*)a.out + DO_MV);
    const float* GT = (const float*)(a.ws + WS_GATES); const float* cw = a.in[4];
    float* HR = (float*)(a.ws + WS_H1);
    float C[8], n[8]; float m = 0.f;
#pragma unroll
    for (int i = 0; i < 8; ++i) { C[i] = 0.f; n[i] = 0.f; }
    for (int c = 0; c < SEQ / 64; ++c) {
        const int t0 = c * 64;
        __syncthreads();
        for (int i = tid; i < 64 * 256; i += 512) { const int tok = i >> 8, ch = i & 255; const bool isk = ch >= 128; const int d = ch & 127;
            const int chg = (isk ? 512 : 0) + h * 128 + d; const h16* src = (isk ? MK : MQ) + h * 128 + d; float y = 0.f;
#pragma unroll
            for (int j = 0; j < 4; ++j) { const int t = t0 + tok - 3 + j; if (t >= 0) y += cw[j * 1024 + chg] * (float)src[(size_t)(b * SEQ + t) * 512]; }
            y = siluf_(y); if (isk) ks[tok * 128 + d] = y * 0.08838834764831845f; else qs[tok * 128 + d] = y; }
        for (int i = tid; i < 64 * 32; i += 512) { const int tok = i >> 5, v = i & 31; vs[tok * 32 + v] = (float)MV[(size_t)(b * SEQ + t0 + tok) * 1024 + h * 256 + slice * 32 + v]; }
        if (tid < 64) { lis[tid] = GT[(size_t)(b * SEQ + t0 + tid) * 8 + h]; lfs[tid] = GT[(size_t)(b * SEQ + t0 + tid) * 8 + 4 + h]; }
        __syncthreads();
        for (int s = 0; s < 64; ++s) {
            const float lf = lfs[s], li = lis[s]; const float mn = fmaxf(lf + m, li); const float fd = expf(lf + m - mn), iw = expf(li - mn); m = mn;
            const float vval = vs[s * 32 + vv] * iw; float ph = 0.f, pn = 0.f;
#pragma unroll
            for (int i = 0; i < 8; ++i) { const float kd = ks[s * 128 + dg * 8 + i], qd = qs[s * 128 + dg * 8 + i]; C[i] = fd * C[i] + kd * vval; n[i] = fd * n[i] + iw * kd; ph += C[i] * qd; pn += n[i] * qd; }
#pragma unroll
            for (int o = 1; o < 16; o <<= 1) { ph += __shfl_xor(ph, o); pn += __shfl_xor(pn, o); }
            if (dg == 0) HR[(size_t)(b * SEQ + t0 + s) * 1024 + h * 256 + slice * 32 + vv] = ph / fmaxf(fabsf(pn), expf(-m));
        }
    }
    __syncthreads();
}

__device__ __forceinline__ void phase_headnorm(const Args& a, LAS unsigned char* lds) {
    LAS float* red = (LAS float*)lds;
    const int tid = threadIdx.x, lane = tid & 63, wave = tid >> 6, sub = tid >> 8, t2 = tid & 255;
    const float* HRb = (const float*)(a.ws + WS_H1); const h16* MGb = (const h16*)(a.ws + WS_MG); h16* MIXb = (h16*)((unsigned char*)a.out + DO_MIX); const float* mnb = a.in[7];
    for (int it = blockIdx.x * 2; it < M * 4; it += gridDim.x * 2) { const int pr = it + sub, row = pr >> 2, h = pr & 3;
        const float v = HRb[(size_t)row * 1024 + h * 256 + t2]; const float s = wave_sum(v * v);
        __syncthreads(); if (lane == 0) red[wave] = s; __syncthreads();
        const float tot = red[sub * 4] + red[sub * 4 + 1] + red[sub * 4 + 2] + red[sub * 4 + 3];
        MIXb[(size_t)row * DMIX + h * 256 + t2] = (h16)(v / sqrtf(tot / 256.f + EPS) * mnb[h * 256 + t2] * (float)MGb[(size_t)row * 1024 + h * 256 + t2]); }
    __syncthreads();
}

__device__ __forceinline__ void index_row_naive(const Args& a, LAS unsigned char* lds, int row) {
    LAS unsigned* keys = (LAS unsigned*)lds; LAS float* qf = (LAS float*)(lds + 32768); LAS unsigned* hist = (LAS unsigned*)(lds + 34816); LAS unsigned* sh = (LAS unsigned*)(lds + 35840);
    const int tid = threadIdx.x, b = row >> 13, t = row & (SEQ - 1);
    const h16* IQ = (const h16*)(a.ws + WS_IQ); const h16* IK = (const h16*)(a.ws + WS_IK); const float* IW = (const float*)(a.ws + WS_IW);
    unsigned* MASK = (unsigned*)(a.ws + WS_MASK) + (size_t)row * 256;
    if (t < 256) { if (tid < 256) { const int lo = tid * 32; unsigned wv = 0; if (t >= lo + 31) wv = 0xffffffffu; else if (t >= lo) wv = (2u << (t - lo)) - 1u; MASK[tid] = wv; } return; }
    __syncthreads();
    qf[tid] = (float)IQ[(size_t)row * 512 + tid];
    float wv[8];
#pragma unroll
    for (int hh = 0; hh < 8; ++hh) wv[hh] = IW[(size_t)row * 8 + hh];
    __syncthreads();
    for (int s = tid; s <= t; s += 512) {
        const h16x8* kr = (const h16x8*)(IK + (size_t)(b * SEQ + s) * 64); float dd[8];
#pragma unroll
        for (int hh = 0; hh < 8; ++hh) dd[hh] = 0.f;
#pragma unroll 1
        for (int j = 0; j < 8; ++j) { const h16x8 q8 = kr[j]; float k8[8];
#pragma unroll
            for (int i = 0; i < 8; ++i) k8[i] = (float)q8[i];
#pragma unroll
            for (int hh = 0; hh < 8; ++hh)
#pragma unroll
                for (int i = 0; i < 8; ++i) dd[hh] += qf[hh * 64 + 8 * j + i] * k8[i]; }
        float sc = 0.f;
#pragma unroll
        for (int hh = 0; hh < 8; ++hh) sc += wv[hh] * fmaxf(dd[hh], 0.f);
        sc += 0.0f;
        const unsigned u = __float_as_uint(sc); keys[s] = (u & 0x80000000u) ? ~u : (u | 0x80000000u);
    }
    unsigned prefix = 0; int krem = 256; unsigned neq = 0;
    for (int pass = 0; pass < 4; ++pass) { const int shift = 24 - 8 * pass;
        if (tid < 256) hist[tid] = 0;
        __syncthreads();
        for (int s = tid; s <= t; s += 512) { const unsigned k = keys[s]; if (pass == 0 || (k >> (shift + 8)) == prefix) __hip_atomic_fetch_add(hist + ((k >> shift) & 255u), 1u, __ATOMIC_RELAXED, __HIP_MEMORY_SCOPE_WORKGROUP); }
        __syncthreads();
        if (tid == 0) { int cum = 0; int d = 255; for (; d > 0; --d) { const int c = (int)hist[d]; if (cum + c >= krem) break; cum += c; } sh[0] = (unsigned)d; sh[1] = (unsigned)(krem - cum); sh[2] = hist[d]; }
        __syncthreads();
        prefix = (prefix << 8) | sh[0]; krem = (int)sh[1]; neq = sh[2];
        __syncthreads();
    }
    const unsigned tau = prefix; int idx_lim = SEQ;
    if ((int)neq != krem) { if (tid == 0) { int cnt = 0, lim = 0; for (int s = 0; s <= t; ++s) if (keys[s] == tau) { if (++cnt == krem) { lim = s; break; } } sh[3] = (unsigned)lim; }
        __syncthreads(); idx_lim = (int)sh[3]; }
    if (tid < 256) { unsigned wv2 = 0; const int lo = tid * 32;
        for (int i = 0; i < 32; ++i) { const int s = lo + i; if (s <= t) { const unsigned k = keys[s]; if (k > tau || (k == tau && s <= idx_lim)) wv2 |= 1u << i; } }
        MASK[tid] = wv2; }
}

__device__ __forceinline__ void attn_row_naive(const Args& a, int row) {
    const int tid = threadIdx.x, lane = tid & 63, h = tid >> 6, b = row >> 13, t = row & (SEQ - 1);
    const h16* AQ = (const h16*)(a.ws + WS_AQ); const h16* AK = (const h16*)(a.ws + WS_AK); const h16* AV = (const h16*)(a.ws + WS_AV); const h16* AZ = (const h16*)(a.ws + WS_AZ);
    const unsigned* MASK = (const unsigned*)(a.ws + WS_MASK) + (size_t)row * 256; const float* BT = (const float*)(a.ws + WS_BT);
    h16* MIX = (h16*)((unsigned char*)a.out + DO_MIX);
    const float q = (float)AQ[(size_t)row * 512 + h * 64 + lane];
    float mx = -1e30f, l = 0.f, o = 0.f;
    const int nw = (t >> 5) + 1;
    for (int w = 0; w < nw; ++w) { unsigned word = MASK[w];
        while (word) { const int bit = __builtin_ctz(word); word &= word - 1; const int s = w * 32 + bit;
            const size_t kr = (size_t)(b * SEQ + s) * 512 + h * 64 + lane;
            const float kv = (float)AK[kr], vv = (float)AV[kr];
            const int dist = t - s; const float x = wave_sum(q * kv) + BT[(dist < 127 ? dist : 127) * 8 + h];
            const float mn = fmaxf(mx, x); const float f = exp2f(mx - mn), p = exp2f(x - mn); l = l * f + p; o = o * f + p * vv; mx = mn; } }
    const float r = o / l * (float)AZ[(size_t)row * 512 + h * 64 + lane];
    MIX[(size_t)row * DMIX + 1024 + h * 64 + lane] = (h16)r;
}

__device__ __forceinline__ void phase_tail(const Args& a) {
    const int lane = threadIdx.x & 63, gw = blockIdx.x * 8 + (threadIdx.x >> 6), NGW = gridDim.x * 8;
    const float* H1 = (const float*)(a.ws + WS_H1); const h16* PB = (const h16*)(a.ws + WS_PB); const float* gf = a.in[11];
    f32x4 gv[4];
#pragma unroll
    for (int j = 0; j < 4; ++j) gv[j] = ((const f32x4*)gf)[lane + 64 * j];
    for (int m = gw; m < M; m += NGW) {
        const f32x4* hr = (const f32x4*)(H1 + (size_t)m * DM) + lane; const h16x4* pr = (const h16x4*)(PB + (size_t)m * DM) + lane; f32x4* o = (f32x4*)(a.out + (size_t)m * DM) + lane;
        f32x4 v[4]; float s = 0.f;
#pragma unroll
        for (int j = 0; j < 4; ++j) { const f32x4 hv = hr[64 * j], g = o[64 * j]; const h16x4 p4 = pr[64 * j];
            v[j].x = hv.x + (float)p4[0] * sigmoidf_(g.x); v[j].y = hv.y + (float)p4[1] * sigmoidf_(g.y); v[j].z = hv.z + (float)p4[2] * sigmoidf_(g.z); v[j].w = hv.w + (float)p4[3] * sigmoidf_(g.w);
            s += (v[j].x * v[j].x + v[j].y * v[j].y) + (v[j].z * v[j].z + v[j].w * v[j].w); }
        const float rstd = 1.0f / sqrtf(wave_sum(s) * (1.0f / DM) + EPS);
        float pen = 0.f;
#if DEBUG_CHECKS
        { const unsigned* flags = (const unsigned*)(a.ws + WS_FLAGS); for (int i = 0; i < 12; ++i) if (i != 8 && __uint_as_float(flags[i]) > 1.0f) pen += (float)(1 << i); }
#endif
#pragma unroll
        for (int j = 0; j < 4; ++j) o[64 * j] = v[j] * rstd * gv[j] + pen;
    }
}


__device__ __forceinline__ void phase_conv(const Args& a) {
    const h16* MQ = (const h16*)((unsigned char*)a.out + DO_MQ); const h16* MK = (const h16*)((unsigned char*)a.out + DO_MK);
    h16* QC = (h16*)(a.ws + WS_QC); h16* KC = (h16*)(a.ws + WS_KC); const float* cw = a.in[4];
    for (int task = blockIdx.x * 512 + threadIdx.x; task < (M / 32) * 1024; task += gridDim.x * 512) {
        const int c = task & 1023, rg = task >> 10, isk = c >> 9, cc = c & 511; const int r0 = rg * 32, tseq = r0 & (SEQ - 1);
        const h16* src = (isk ? MK : MQ) + cc; h16* dst = (isk ? KC : QC) + cc;
        const float w0 = cw[c], w1 = cw[1024 + c], w2 = cw[2048 + c], w3 = cw[3072 + c]; const float sc = isk ? 0.08838834764831845f : 1.0f;
        float x0 = tseq ? (float)src[(size_t)(r0 - 3) * 512] : 0.f, x1 = tseq ? (float)src[(size_t)(r0 - 2) * 512] : 0.f, x2 = tseq ? (float)src[(size_t)(r0 - 1) * 512] : 0.f;
#pragma unroll 8
        for (int i = 0; i < 32; ++i) { const float x3 = (float)src[(size_t)(r0 + i) * 512]; const float y = w0 * x0 + w1 * x1 + w2 * x2 + w3 * x3;
            dst[(size_t)(r0 + i) * 512] = (h16)(siluf_(y) * sc); x0 = x1; x1 = x2; x2 = x3; }
    }
}
__device__ __forceinline__ void phase_headnorm2(const Args& a) {
    const int lane = threadIdx.x & 63, gw = blockIdx.x * 8 + (threadIdx.x >> 6), NGW = gridDim.x * 8;
    const float* HR = (const float*)(a.ws + WS_H1); const h16* MG = (const h16*)(a.ws + WS_MG); h16* MIX = (h16*)((unsigned char*)a.out + DO_MIX); const float* mn = a.in[7];
    for (int it = gw; it < M * 4; it += NGW) { const int row = it >> 2, h = it & 3;
        const f32x4 v = ((const f32x4*)(HR + (size_t)row * 1024 + h * 256))[lane]; const h16x4 mg = ((const h16x4*)(MG + (size_t)row * 1024 + h * 256))[lane]; const f32x4 g = ((const f32x4*)(mn + h * 256))[lane];
        const float ss = wave_sum(v.x * v.x + v.y * v.y + v.z * v.z + v.w * v.w); const float r = 1.0f / sqrtf(ss * (1.0f / 256.0f) + EPS);
        h16x4 o; o[0] = (h16)(v.x * r * g.x * (float)mg[0]); o[1] = (h16)(v.y * r * g.y * (float)mg[1]); o[2] = (h16)(v.z * r * g.z * (float)mg[2]); o[3] = (h16)(v.w * r * g.w * (float)mg[3]);
        ((h16x4*)(MIX + (size_t)row * DMIX + h * 256))[lane] = o; }
}

namespace mls {
using f32x16 = __attribute__((ext_vector_type(16))) float;
typedef __attribute__((address_space(3))) const char* lcp;
typedef __attribute__((address_space(3))) char* lp;
constexpr int LDQ = 272, LDT = 144;
constexpr int O_QS = 0, O_QW = 17408, O_KS = 34816, O_KTW = 52224, O_VT = 70656, O_PS = 75264, O_CT = 84480, O_G = 101888, O_N = 103424, O_QN = 103936, O_DEN = 104192, O_HS = 104448, MLS_LDS = 104448 + 64 * 144;
__device__ __forceinline__ int crow(int r, int hi) { return (r & 3) + 8 * (r >> 2) + 4 * hi; }
__device__ __forceinline__ float scan_add(float x) {
#define SA_STEP(ctrl, rmask) x += __uint_as_float((unsigned)__builtin_amdgcn_update_dpp(0, (int)__float_as_uint(x), ctrl, rmask, 0xf, false))
    SA_STEP(0x111, 0xf); SA_STEP(0x112, 0xf); SA_STEP(0x114, 0xf); SA_STEP(0x118, 0xf); SA_STEP(0x142, 0xa); SA_STEP(0x143, 0xc);
#undef SA_STEP
    return x;
}
__device__ __forceinline__ float scan_max(float x) {
#define SM_STEP(ctrl, rmask) x = fmaxf(x, __uint_as_float((unsigned)__builtin_amdgcn_update_dpp((int)0xff800000u, (int)__float_as_uint(x), ctrl, rmask, 0xf, false)))
    SM_STEP(0x111, 0xf); SM_STEP(0x112, 0xf); SM_STEP(0x114, 0xf); SM_STEP(0x118, 0xf); SM_STEP(0x142, 0xa); SM_STEP(0x143, 0xc);
#undef SM_STEP
    return x;
}
template <int KS> __device__ __forceinline__ void mma_tile(f32x16& acc, lcp A, int lda, lcp B, int ldb, int r32, int hi) {
    const lcp ap = A + r32 * lda + hi * 16, bp = B + r32 * ldb + hi * 16;
#pragma unroll
    for (int k = 0; k < KS; ++k) { const h16x8 a = *(const LAS h16x8*)(ap + k * 32), b = *(const LAS h16x8*)(bp + k * 32); acc = __builtin_amdgcn_mfma_f32_32x32x16_f16(a, b, acc, 0, 0, 0); }
}
__device__ __forceinline__ void phase_mlstm(const Args& a, LAS unsigned char* ldsb, int blk) {
    const lp lds = (lp)ldsb;
    const int tid = threadIdx.x, lane = tid & 63, r32 = lane & 31, hi = lane >> 5; const int wid = __builtin_amdgcn_readfirstlane(tid >> 6);
    const int bh = blk & 7, slice = blk >> 3, b = bh >> 2, h = bh & 3;
    const h16* MV = (const h16*)((unsigned char*)a.out + DO_MV);
    const float* GT = (const float*)(a.ws + WS_GATES);
    float* HR = (float*)(a.ws + WS_H1);
    LAS float* Gs = (LAS float*)(lds + O_G);
    LAS float* nv = (LAS float*)(lds + O_N); LAS float* qn = (LAS float*)(lds + O_QN); LAS float* denv = (LAS float*)(lds + O_DEN);
    const h16* QC = (const h16*)(a.ws + WS_QC) + (size_t)b * SEQ * 512 + h * 128; const h16* KC = (const h16*)(a.ws + WS_KC) + (size_t)b * SEQ * 512 + h * 128;
    const int ptok = tid >> 4, pcol = tid & 15;
    const int vtok = tid >> 3, v4 = (tid & 7) * 4;
    const h16* vp = MV + (size_t)b * SEQ * 1024 + h * 256 + slice * 32 + v4;
    for (int i = tid; i < (O_G - O_PS) / 4; i += 512) ((LAS unsigned*)(lds + O_PS))[i] = 0u;
    if (tid < 128) nv[tid] = 0.f;
    f32x16 Cacc;
#pragma unroll
    for (int r = 0; r < 16; ++r) Cacc[r] = 0.f;
    float m_prev = 0.f; int cur = 0;
    h16x8 qraw[2], kraw[2]; h16x4 vraw; float lf_n, li_n;
#pragma unroll
    for (int i = 0; i < 2; ++i) { qraw[i] = *(const h16x8*)(QC + (size_t)(ptok + 32 * i) * 512 + pcol * 8); kraw[i] = *(const h16x8*)(KC + (size_t)(ptok + 32 * i) * 512 + pcol * 8); }
    vraw = *(const h16x4*)(vp + (size_t)vtok * 1024);
    lf_n = GT[(size_t)(b * SEQ + lane) * 8 + 4 + h]; li_n = GT[(size_t)(b * SEQ + lane) * 8 + h];
    __syncthreads();
    for (int c = 0; c < SEQ / 64; ++c) {
        const int t0 = c * 64;
        const float lf = lf_n, li = li_n;
        const float bq = scan_add(lf);
        const float av = li - bq; const float A = scan_max(av);
        const float g = fmaxf(m_prev, A);
        const float g63 = __shfl(g, 63), bL = __shfl(bq, 63);
        const float winter = __expf(m_prev - g), wk = __expf(av - g63), decay = __expf(m_prev - g63);
        if (wid == 0) { Gs[64 + lane] = __expf(fminf(g63 - g, 80.f)); Gs[128 + lane] = __expf(-(bq + g)); Gs[192 + lane] = wk; }
#pragma unroll
        for (int i = 0; i < 2; ++i) { const int tok = ptok + 32 * i; const h16 wi = (h16)__shfl(winter, tok); const float wkt = __shfl(wk, tok);
            *(LAS h16x8*)(lds + O_QS + tok * LDQ + pcol * 16) = qraw[i]; *(LAS h16x8*)(lds + O_QW + tok * LDQ + pcol * 16) = qraw[i] * wi;
            *(LAS h16x8*)(lds + O_KS + tok * LDQ + pcol * 16) = kraw[i];
            const lp ktb = lds + O_KTW + (pcol * 8) * LDT + ((tok ^ ((pcol & 7) << 3)) * 2);
#pragma unroll
            for (int j = 0; j < 8; ++j) *(LAS h16*)(ktb + j * LDT) = (h16)((float)kraw[i][j] * wkt); }
#pragma unroll
        for (int j = 0; j < 4; ++j) *(LAS h16*)(lds + O_VT + (v4 + j) * LDT + vtok * 2) = vraw[j];
        __syncthreads();
        if (c > 0) { const f32x4 hv = *(const LAS f32x4*)(lds + O_HS + (tid >> 3) * 144 + (tid & 7) * 16);
            *(f32x4*)(HR + (size_t)(b * SEQ + t0 - 64 + (tid >> 3)) * 1024 + h * 256 + slice * 32 + (tid & 7) * 4) = hv; }
        { const int tn = (c + 1 < SEQ / 64) ? t0 + 64 : t0;
#pragma unroll
          for (int i = 0; i < 2; ++i) { qraw[i] = *(const h16x8*)(QC + (size_t)(tn + ptok + 32 * i) * 512 + pcol * 8); kraw[i] = *(const h16x8*)(KC + (size_t)(tn + ptok + 32 * i) * 512 + pcol * 8); }
          vraw = *(const h16x4*)(vp + (size_t)(tn + vtok) * 1024);
          lf_n = GT[(size_t)(b * SEQ + tn + lane) * 8 + 4 + h]; li_n = GT[(size_t)(b * SEQ + tn + lane) * 8 + h]; }
        if (wid < 3) {
            const int lb = wid ? 1 : 0, sb = wid == 2 ? 1 : 0;
            f32x16 S;
#pragma unroll
            for (int r = 0; r < 16; ++r) S[r] = 0.f;
            mma_tile<8>(S, lds + O_QS + lb * 32 * LDQ, LDQ, lds + O_KS + sb * 32 * LDQ, LDQ, r32, hi);
            const float ws = Gs[192 + 32 * sb + r32]; const int spos = 32 * sb + r32;
            const LAS float* gb = Gs + 64 + 32 * lb + 4 * hi; const lp pb = lds + O_PS + (32 * lb + 4 * hi) * LDT + spos * 2; const int l0 = 32 * lb + 4 * hi;
            f32x4 g4[4];
#pragma unroll
            for (int q4 = 0; q4 < 4; ++q4) g4[q4] = *(const LAS f32x4*)(gb + 8 * q4);
#pragma unroll
            for (int r = 0; r < 16; ++r) { const int ro = (r & 3) + 8 * (r >> 2); const float p = (spos <= l0 + ro) ? S[r] * ws * g4[r >> 2][r & 3] : 0.f;
                *(LAS h16*)(pb + ro * LDT) = (h16)p; }
        } else if (wid < 7) {
            const int j = wid - 3;
#pragma unroll
            for (int r = 0; r < 16; ++r) asm volatile("v_mul_f32 %0, %0, %1" : "+v"(Cacc[r]) : "v"(decay));
            { const lcp ap = lds + O_VT + r32 * LDT + hi * 16, bp = lds + O_KTW + (32 * j + r32) * LDT; const int sw = (4 * j + (r32 >> 3)) & 7;
#pragma unroll
              for (int k = 0; k < 4; ++k) { const h16x8 av8 = *(const LAS h16x8*)(ap + k * 32), bv8 = *(const LAS h16x8*)(bp + (((2 * k + hi) ^ sw) * 16)); Cacc = __builtin_amdgcn_mfma_f32_32x32x16_f16(av8, bv8, Cacc, 0, 0, 0); } }
            const lp cb = lds + O_CT + (cur ^ 1) * 8704 + (4 * hi) * LDQ + (32 * j + r32) * 2;
#pragma unroll
            for (int r = 0; r < 16; ++r) *(LAS h16*)(cb + ((r & 3) + 8 * (r >> 2)) * LDQ) = (h16)Cacc[r];
            { const int row = 16 * j + (lane >> 2), dq = lane & 3; float s4[4] = {0.f, 0.f, 0.f, 0.f};
#pragma unroll
              for (int d8 = 0; d8 < 4; ++d8) { const h16x8 q8 = *(const LAS h16x8*)(lds + O_QW + row * LDQ + (dq * 4 + d8) * 16); const f32x4 n0 = *(const LAS f32x4*)(nv + 32 * dq + 8 * d8), n1 = *(const LAS f32x4*)(nv + 32 * dq + 8 * d8 + 4);
                  s4[0] += (float)q8[0] * n0[0] + (float)q8[4] * n1[0]; s4[1] += (float)q8[1] * n0[1] + (float)q8[5] * n1[1]; s4[2] += (float)q8[2] * n0[2] + (float)q8[6] * n1[2]; s4[3] += (float)q8[3] * n0[3] + (float)q8[7] * n1[3]; }
              float s = (s4[0] + s4[1]) + (s4[2] + s4[3]); s += __shfl_xor(s, 1); s += __shfl_xor(s, 2);
              if (dq == 0) qn[row] = s; }
        } else {
        }
        __syncthreads();
        if (wid >= 3 && wid < 7) {
            const int d = 32 * (wid - 3) + (lane >> 1), sh = lane & 1; float k4[4] = {0.f, 0.f, 0.f, 0.f};
#pragma unroll
            for (int s8 = 0; s8 < 4; ++s8) { const h16x8 k8 = *(const LAS h16x8*)(lds + O_KTW + d * LDT + (4 * sh + s8) * 16);
                k4[0] += (float)k8[0] + (float)k8[4]; k4[1] += (float)k8[1] + (float)k8[5]; k4[2] += (float)k8[2] + (float)k8[6]; k4[3] += (float)k8[3] + (float)k8[7]; }
            float ks = (k4[0] + k4[1]) + (k4[2] + k4[3]); ks += __shfl_xor(ks, 1);
            if (sh == 0) nv[d] = decay * nv[d] + ks;
        }
        f32x16 N;
        if (wid < 2) {
#pragma unroll
            for (int r = 0; r < 16; ++r) N[r] = 0.f;
            if (wid == 0) mma_tile<2>(N, lds + O_PS, LDT, lds + O_VT, LDT, r32, hi); else mma_tile<4>(N, lds + O_PS + 32 * LDT, LDT, lds + O_VT, LDT, r32, hi);
            mma_tile<8>(N, lds + O_QW + wid * 32 * LDQ, LDQ, lds + O_CT + cur * 8704, LDQ, r32, hi);
        } else if (wid == 2) {
            float p4[4] = {0.f, 0.f, 0.f, 0.f};
#pragma unroll
            for (int s8 = 0; s8 < 8; ++s8) { const h16x8 p8 = *(const LAS h16x8*)(lds + O_PS + lane * LDT + s8 * 16);
                p4[0] += (float)p8[0] + (float)p8[4]; p4[1] += (float)p8[1] + (float)p8[5]; p4[2] += (float)p8[2] + (float)p8[6]; p4[3] += (float)p8[3] + (float)p8[7]; }
            denv[lane] = __builtin_amdgcn_rcpf(fmaxf(fabsf(((p4[0] + p4[1]) + (p4[2] + p4[3])) + qn[lane]), Gs[128 + lane]));
        }
        __syncthreads();
        if (wid < 2) {
            const LAS float* db = denv + 32 * wid + 4 * hi; const lp hsb = lds + O_HS + (32 * wid + 4 * hi) * 144 + r32 * 4;
#pragma unroll
            for (int r = 0; r < 16; ++r) *(LAS float*)(hsb + ((r & 3) + 8 * (r >> 2)) * 144) = N[r] * db[(r & 3) + 8 * (r >> 2)];
        }
        m_prev = bL + g63; cur ^= 1;
    }
    __syncthreads();
    { const f32x4 hv = *(const LAS f32x4*)(lds + O_HS + (tid >> 3) * 144 + (tid & 7) * 16);
      *(f32x4*)(HR + (size_t)(b * SEQ + SEQ - 64 + (tid >> 3)) * 1024 + h * 256 + slice * 32 + (tid & 7) * 4) = hv; }
    __syncthreads();
}
}

namespace idx {
using f32x16 = __attribute__((ext_vector_type(16))) float;
typedef __attribute__((address_space(3))) char* lp;
constexpr int IDX_CAP = 256;
constexpr int O_HIST = 0;
constexpr int O_LIST = 0, O_IMG = 65536;
constexpr int O_QF = 98304, O_W = 131072 + 1024;
constexpr int O_MISC = 131072 + 2048;
__device__ __forceinline__ int crow(int r, int hi) { return (r & 3) + 8 * (r >> 2) + 4 * hi; }
__device__ __forceinline__ int bin_of(float x) {
    const unsigned u = __float_as_uint(x); int e5 = (int)((u & 0x7fffffffu) >> 18) - 3744; e5 = e5 < 0 ? 0 : (e5 > 511 ? 511 : e5);
    return (u >> 31) ? 511 - e5 : 512 + e5;
}
__device__ __forceinline__ void load_kfrag(h16x8 (&af)[4], const h16* IKb, int kb, int r32, int hi) {
    const h16* p = IKb + (size_t)(32 * kb + r32) * 64 + 8 * hi;
#pragma unroll
    for (int k = 0; k < 4; ++k) af[k] = *(const h16x8*)(p + 16 * k);
}
__device__ __forceinline__ void score_block(f32x16& sc, const h16x8 (&af)[4], lp qimg, lp wimg) {
#pragma unroll
    for (int r = 0; r < 16; ++r) sc[r] = 0.f;
#pragma unroll 1
    for (int h = 0; h < 8; ++h) { f32x16 acc;
#pragma unroll
        for (int r = 0; r < 16; ++r) acc[r] = 0.f;
        const float wh = *(const LAS float*)(wimg + h * 128);
#pragma unroll
        for (int k = 0; k < 4; ++k) { const h16x8 qf = *(const LAS h16x8*)(qimg + (h * 4 + k) * 1024); acc = __builtin_amdgcn_mfma_f32_32x32x16_f16(af[k], qf, acc, 0, 0, 0); }
#pragma unroll
        for (int r = 0; r < 16; ++r) sc[r] = fmaf(wh, fmaxf(acc[r], 0.f), sc[r]); }
#pragma unroll
    for (int r = 0; r < 16; ++r) sc[r] += 0.0f;
}
__device__ __forceinline__ void hist_add(LAS unsigned* hist, int q, int bin) { __hip_atomic_fetch_add(hist + q * 512 + ((bin >> 1) ^ q), 1u << (16 * (bin & 1)), __ATOMIC_RELAXED, __HIP_MEMORY_SCOPE_WORKGROUP); }
__device__ __forceinline__ unsigned hist_get(const LAS unsigned* hist, int q, int bin) { return (hist[q * 512 + ((bin >> 1) ^ q)] >> (16 * (bin & 1))) & 0xffffu; }
__device__ __forceinline__ void index_unit(const Args& a, LAS unsigned char* ldsb, int b, int qblk) {
    const lp lds = (lp)ldsb;
    const int tid = threadIdx.x, lane = tid & 63, r32 = lane & 31, hi = lane >> 5; const int wid = __builtin_amdgcn_readfirstlane(tid >> 6);
    const h16* IQ = (const h16*)(a.ws + WS_IQ); const h16* IKb = (const h16*)(a.ws + WS_IK) + (size_t)b * SEQ * 64; const float* IW = (const float*)(a.ws + WS_IW);
    unsigned long long* MB = (unsigned long long*)(a.ws + WS_MASKB) + ((size_t)(b * 256 + qblk) * 256) * 16;
    LAS unsigned* hist = (LAS unsigned*)(lds + O_HIST); LAS unsigned long long* list = (LAS unsigned long long*)(lds + O_LIST); LAS unsigned long long* img = (LAS unsigned long long*)(lds + O_IMG);
    LAS int* bstar = (LAS int*)(lds + O_MISC); LAS int* cabove = bstar + 32; LAS unsigned* cnt = (LAS unsigned*)(bstar + 64);
    const int q0 = 32 * qblk, kblim = (qblk | 7);
    if (qblk < 8) {
        for (int kb = wid; kb <= kblim; kb += 8) { unsigned long long mine = 0ull;
#pragma unroll
            for (int r = 0; r < 16; ++r) { const unsigned long long bal = __ballot(32 * kb + crow(r, hi) <= q0 + r32); if (lane == r) mine = bal; }
            if (lane < 16) MB[(size_t)kb * 16 + lane] = mine; }
        return;
    }
    { const int pr = tid >> 1;
#pragma unroll
      for (int i = 0; i < 4; ++i) { const int piece = tid * 4 + i, rq = piece & 31, hh = (piece >> 5) & 1, k = (piece >> 6) & 3, h = piece >> 8;
          *(LAS h16x8*)(lds + O_QF + piece * 16) = *(const h16x8*)(IQ + (size_t)(b * SEQ + q0 + rq) * 512 + h * 64 + 16 * k + 8 * hh); }
      (void)pr;
      if (tid < 256) *(LAS float*)(lds + O_W + (tid & 7) * 128 + (tid >> 3) * 4) = IW[(size_t)(b * SEQ + q0 + (tid >> 3)) * 8 + (tid & 7)]; }
    const lp qimg = lds + O_QF + hi * 512 + r32 * 16, wimg = lds + O_W + r32 * 4;
    const int tq = q0 + r32;
    { u32x4* hz = (u32x4*)(lds + O_HIST);
#pragma unroll
      for (int i = 0; i < 8; ++i) *(LAS u32x4*)(lds + O_HIST + (tid + 512 * i) * 16) = (u32x4){0, 0, 0, 0};
      (void)hz; }
    __syncthreads();
    { h16x8 af[4], afn[4]; f32x16 sc;
      if (wid <= qblk) load_kfrag(af, IKb, wid, r32, hi);
      for (int kb = wid; kb <= qblk; kb += 8) {
          if (kb + 8 <= qblk) load_kfrag(afn, IKb, kb + 8, r32, hi);
          score_block(sc, af, qimg, wimg);
#pragma unroll
          for (int r = 0; r < 16; ++r) { const int key = 32 * kb + crow(r, hi);
              if (key <= tq) hist_add(hist, r32, bin_of(sc[r])); }
#pragma unroll
          for (int k = 0; k < 4; ++k) af[k] = afn[k];
      } }
    __syncthreads();
    { const int q = tid >> 4, seg = tid & 15; unsigned s = 0;
      for (int i = 0; i < 64; ++i) s += hist_get(hist, q, 64 * seg + i);
      unsigned above = 0;
#pragma unroll
      for (int o = 1; o < 16; ++o) { const unsigned t = __shfl(s, (lane & 48) | ((seg + o) & 15)); if (seg + o < 16) above += t; }
      if (above < 256u && above + s >= 256u) { unsigned cum = above; int bsel = 64 * seg;
          for (int i = 63; i >= 0; --i) { const unsigned c = hist_get(hist, q, 64 * seg + i); if (cum + c >= 256u) { bsel = 64 * seg + i; break; } cum += c; }
          bstar[q] = bsel; cabove[q] = (int)cum; }
      if (tid < 32) cnt[tid] = 0u; }
    __syncthreads();
    { h16x8 af[4], afn[4]; f32x16 sc; const int bs = bstar[r32];
      if (wid <= qblk) load_kfrag(af, IKb, wid, r32, hi);
      for (int kb = wid; kb <= qblk; kb += 8) {
          if (kb + 8 <= qblk) load_kfrag(afn, IKb, kb + 8, r32, hi);
          score_block(sc, af, qimg, wimg);
          unsigned long long mine = 0ull;
#pragma unroll
          for (int r = 0; r < 16; ++r) { const int key = 32 * kb + crow(r, hi); const int bn = bin_of(sc[r]); const bool valid = key <= tq;
              const unsigned long long bal = __ballot(valid && bn > bs); if (lane == r) mine = bal;
              if (valid && bn == bs) { const unsigned pos = __hip_atomic_fetch_add(cnt + r32, 1u, __ATOMIC_RELAXED, __HIP_MEMORY_SCOPE_WORKGROUP);
                  const unsigned u = __float_as_uint(sc[r]); const unsigned ok = (u & 0x80000000u) ? ~u : (u | 0x80000000u);
                  if (pos < (unsigned)IDX_CAP) list[r32 * IDX_CAP + pos] = ((unsigned long long)ok << 32) | (unsigned)(0xffffffffu - (unsigned)key); } }
          if (lane < 16) img[kb * 16 + lane] = mine;
#pragma unroll
          for (int k = 0; k < 4; ++k) af[k] = afn[k];
      }
      for (int kb = qblk + 1 + wid; kb <= kblim; kb += 8) if (lane < 16) img[kb * 16 + lane] = 0ull; }
    __syncthreads();
    { const int q = tid >> 4, seg = tid & 15; const int n = (int)min(cnt[q], (unsigned)IDX_CAP), need = 256 - cabove[q];
      for (int i = seg; i < n; i += 16) { const unsigned long long e = list[q * IDX_CAP + i]; int rank = 0;
          for (int j = 0; j < n; ++j) rank += (list[q * IDX_CAP + j] > e) ? 1 : 0;
          if (rank < need) { const unsigned key = 0xffffffffu - (unsigned)(e & 0xffffffffu); const int kk = key & 31, kb = key >> 5, h2 = (kk >> 2) & 1, r = (kk & 3) + 4 * (kk >> 3);
              __hip_atomic_fetch_or((LAS unsigned*)(img + kb * 16 + r) + h2, 1u << q, __ATOMIC_RELAXED, __HIP_MEMORY_SCOPE_WORKGROUP); } } }
    __syncthreads();
    for (int i = tid; i < (kblim + 1) * 16; i += 512) MB[i] = img[i];
    __syncthreads();
}
__device__ __forceinline__ void phase_index(const Args& a, LAS unsigned char* lds) {
    unsigned* qhead = (unsigned*)(a.ws + WS_CTL) + 2048; LAS unsigned* uslot = (LAS unsigned*)(lds + O_MISC + 512);
    for (;;) {
        if (threadIdx.x == 0) *uslot = __hip_atomic_fetch_add(qhead, 1u, __ATOMIC_RELAXED, __HIP_MEMORY_SCOPE_AGENT);
        __syncthreads();
        const unsigned u = *uslot;
        __syncthreads();
        if (u >= 512u) break;
        index_unit(a, lds, (int)(u & 1u), 255 - (int)(u >> 1));
    }
}
}

namespace attn_body {
using s16x4=__attribute__((ext_vector_type(4)))short;
using f32x16=__attribute__((ext_vector_type(16)))float;
constexpr int NHEAD=8,D=64,APITCH=512;
constexpr int NW=8,QBLK=32,QB=QBLK*NW,KVBLK=64;
__device__ __forceinline__ int crow(int r,int hi){return (r&3)+8*(r>>2)+4*hi;}
#define SBAR() __builtin_amdgcn_sched_barrier(0)
constexpr int NSLOT=3, SLOTB=8192;
constexpr int LDS_K=0, LDS_V=NSLOT*SLOTB, LDS_WS=2*NSLOT*SLOTB, LDS_OST=LDS_WS+NW*64*4, LDS_BT=LDS_OST+NW*4096, LDS_BYTES=LDS_BT+128*4;
__device__ __forceinline__ void glds16(const void*gsrc,unsigned lds_dst){unsigned keep;
  asm volatile("s_mov_b32 %0, m0\n\ts_mov_b32 m0, %2\n\ts_nop 0\n\tglobal_load_lds_dwordx4 %1, off\n\ts_mov_b32 m0, %0":"=&s"(keep):"v"(gsrc),"s"(lds_dst):"memory");}
__device__ __forceinline__ float max3f(float a,float b,float c){float r;asm("v_max3_f32 %0, %1, %2, %3":"=v"(r):"v"(a),"v"(b),"v"(c));return r;}
__device__ __forceinline__ float max2f(float a,float b){float r;asm("v_max_f32_e32 %0, %1, %2":"=v"(r):"v"(a),"v"(b));return r;}
__device__ __forceinline__ float fadd_s(float a,float b){float r;asm("v_add_f32_e32 %0, %1, %2":"=v"(r):"v"(a),"v"(b));return r;}
__device__ __forceinline__ float fsub_s(float a,float b){float r;asm("v_sub_f32_e32 %0, %1, %2":"=v"(r):"v"(a),"v"(b));return r;}
__device__ __forceinline__ unsigned cvtpk_s(float lo,float hi){f32x2 v={lo,hi};h16x2 b=__builtin_convertvector(v,h16x2);return __builtin_bit_cast(unsigned,b);}
#define WAIT_BAR(N) asm volatile("s_waitcnt vmcnt(" #N ") lgkmcnt(0)\n\ts_barrier":::"memory")
#define MFMA16(a,b,c) __builtin_amdgcn_mfma_f32_32x32x16_f16(a,b,c,0,0,0)
typedef __attribute__((address_space(3))) const char* lds_cptr;
typedef short v4i16_t __attribute__((ext_vector_type(4)));
__device__ __forceinline__ void kload8(h16x8*kf,lds_cptr kp){
  kf[0]=*(const __attribute__((address_space(3))) h16x8*)(kp);      kf[1]=*(const __attribute__((address_space(3))) h16x8*)(kp+512);
  kf[2]=*(const __attribute__((address_space(3))) h16x8*)(kp+2048); kf[3]=*(const __attribute__((address_space(3))) h16x8*)(kp+2560);
  kf[4]=*(const __attribute__((address_space(3))) h16x8*)(kp+4096); kf[5]=*(const __attribute__((address_space(3))) h16x8*)(kp+4608);
  kf[6]=*(const __attribute__((address_space(3))) h16x8*)(kp+6144); kf[7]=*(const __attribute__((address_space(3))) h16x8*)(kp+6656);
}
__device__ __forceinline__ void kload2(h16x8*kf,lds_cptr kp,int j){ kf[2*j]=*(const __attribute__((address_space(3))) h16x8*)(kp+j*2048); kf[2*j+1]=*(const __attribute__((address_space(3))) h16x8*)(kp+j*2048+512); }
__device__ __forceinline__ s16x4 vtr(lds_cptr p){ return __builtin_bit_cast(s16x4,__builtin_amdgcn_ds_read_tr16_b64_v4i16((__attribute__((address_space(3))) v4i16_t*)p)); }
__device__ __forceinline__ h16x8 vfr(s16x4 lo,s16x4 hi){ return __builtin_bit_cast(h16x8,__builtin_shufflevector(lo,hi,0,1,2,3,4,5,6,7)); }
__device__ __forceinline__ void qkt(f32x16&p0,f32x16&p1,const char*Kslot,const h16x8*qr,int r32,int hi){ const f32x16 negm=f32x16{};
  const char*kb=Kslot+hi*1024+r32*16;
  #pragma unroll
  for(int d0=0;d0<4;++d0){
    const h16x8 b0=*reinterpret_cast<const h16x8*>(kb+d0*2048);
    const h16x8 b1=*reinterpret_cast<const h16x8*>(kb+d0*2048+512);
    if(d0==0){p0=MFMA16(b0,qr[0],negm);p1=MFMA16(b1,qr[0],negm);}
    else{p0=MFMA16(b0,qr[d0],p0);p1=MFMA16(b1,qr[d0],p1);}}
}
__device__ __forceinline__ float rowmax(const f32x16&p0,const f32x16&p1){
  float a=max3f(p0[0],p0[1],p1[0]),b=max3f(p0[2],p0[3],p1[1]);a=max3f(a,p1[2],p1[3]);
  #pragma unroll
  for(int r=4;r<16;r+=4){a=max3f(a,p0[r],p0[r+1]);b=max3f(b,p0[r+2],p0[r+3]);a=max3f(a,p1[r],p1[r+1]);b=max3f(b,p1[r+2],p1[r+3]);}
  const float m=max2f(a,b);
  auto rr=__builtin_amdgcn_permlane32_swap(__float_as_uint(m),__float_as_uint(m),false,false);
  return max2f(__uint_as_float(rr[0]),__uint_as_float(rr[1]));
}
__device__ __forceinline__ void pv(f32x16*o,int vb,h16x8 pa0,h16x8 pa1,h16x8 pa2,h16x8 pa3){
  #pragma unroll
  for(int d0=0;d0<2;++d0){s16x4 lo[4],hi[4];
    #pragma unroll
    for(int ks=0;ks<4;++ks){
      asm volatile("ds_read_b64_tr_b16 %0,%1 offset:%c2":"=&v"(lo[ks]):"v"(vb),"i"(d0*4096+ks*1024):"memory");
      asm volatile("ds_read_b64_tr_b16 %0,%1 offset:%c2":"=&v"(hi[ks]):"v"(vb),"i"(d0*4096+ks*1024+512):"memory");}
    asm volatile("s_waitcnt lgkmcnt(0)":::"memory");SBAR();
    o[d0]=MFMA16(pa0,vfr(lo[0],hi[0]),o[d0]);
    o[d0]=MFMA16(pa1,vfr(lo[1],hi[1]),o[d0]);
    o[d0]=MFMA16(pa2,vfr(lo[2],hi[2]),o[d0]);
    o[d0]=MFMA16(pa3,vfr(lo[3],hi[3]),o[d0]);
  }
}
__device__ __forceinline__ void amask(f32x16&p0,f32x16&p1,unsigned long long mw){
  const float NEG=-INFINITY; const unsigned lo=(unsigned)mw,hi32=(unsigned)(mw>>32);
  #pragma unroll
  for(int r=0;r<16;++r){ const unsigned long long m=((unsigned long long)(unsigned)__builtin_amdgcn_readlane((int)hi32,r)<<32)|(unsigned)__builtin_amdgcn_readlane((int)lo,r); p0[r]=__builtin_amdgcn_inverse_ballot_w64(m)?p0[r]:NEG; }
  #pragma unroll
  for(int r=0;r<16;++r){ const unsigned long long m=((unsigned long long)(unsigned)__builtin_amdgcn_readlane((int)hi32,16+r)<<32)|(unsigned)__builtin_amdgcn_readlane((int)lo,16+r); p1[r]=__builtin_amdgcn_inverse_ballot_w64(m)?p1[r]:NEG; }
}
__device__ __forceinline__ void abias(f32x16&p0,f32x16&p1,const float*bt,int qpos,int kbase,int hi){
  #pragma unroll
  for(int r=0;r<16;++r){ int d0=qpos-(kbase+(r&3)+8*(r>>2)+4*hi); int d1=d0-32; d0=d0<0?0:(d0>127?127:d0); d1=d1<0?0:(d1>127?127:d1); p0[r]+=bt[d0]; p1[r]+=bt[d1]; }
}

template<int THRL> __device__ __forceinline__ void attn_unit(int b,int h,int qb,const h16*Q,const h16*__restrict__ K,const h16*__restrict__ V,const h16*AZ,h16*MIXO,const unsigned long long*MASKB,const float*BT,char*shm){
  const int tid=threadIdx.x,lane=tid&63,r32=lane&31,hi=lane>>5; const int wid=__builtin_amdgcn_readfirstlane(tid>>6);
  const long rowbase=(long)b*SEQ; const int q0=qb*QB;
  const h16*Qw=Q+(rowbase+q0+wid*QBLK)*APITCH+h*D;
  const h16*Kh=K+rowbase*APITCH+h*D,*Vh=V+rowbase*APITCH+h*D;
  const unsigned lds0=(unsigned)(uintptr_t)shm;
  float*wsf=(float*)(shm+LDS_WS)+wid*64;
  float*btl=(float*)(shm+LDS_BT);
  if(tid<128)btl[tid]=BT[tid*8+h];
  const h16*ksrc=Kh+(long)lane*APITCH+wid*8;
  const h16*vsrc=Vh+(long)(16*(wid&3)+(lane>>2))*APITCH+(wid>>2)*32+(lane&3)*8;
  const unsigned kdst=lds0+LDS_K+wid*1024, vdst=lds0+LDS_V+wid*1024;
  #define DMA_K(t,slot) glds16(ksrc+(long)(t)*KVBLK*APITCH,(unsigned)__builtin_amdgcn_readfirstlane(kdst+(slot)))
  #define DMA_V(t,slot) glds16(vsrc+(long)(t)*KVBLK*APITCH,(unsigned)__builtin_amdgcn_readfirstlane(vdst+(slot)))
  const int vb0=(int)(lds0+LDS_V)+((lane>>4)&1)*32+(lane&3)*8+(4*hi+((lane&15)>>2))*64;
  const char*Kbase=shm+LDS_K; h16x8 kf[8];
  const lds_cptr shm3=(lds_cptr)shm; const lds_cptr kp0=shm3+LDS_K+hi*1024+r32*16; const lds_cptr vp0=shm3+LDS_V+((lane>>4)&1)*32+(lane&3)*8+(4*hi+((lane&15)>>2))*64;
  const int NT=(q0+QB)/KVBLK;
  const unsigned long long*mrowv=MASKB+((size_t)(b*256+(q0>>5)+wid)*256)*16+(lane&31);
  unsigned long long mw=mrowv[0];
  DMA_K(0,0);DMA_V(0,0);DMA_K(1,SLOTB);
  h16x8 qr[4];
  #pragma unroll
  for(int d0=0;d0<4;++d0)qr[d0]=*reinterpret_cast<const h16x8*>(&Qw[(long)r32*APITCH+d0*16+hi*8]);
  float mhat=0.f,l_reg=0.f;f32x16 o[2];o[0]=f32x16{};o[1]=f32x16{};
  const int qpos=q0+wid*QBLK+r32;
  #define AMASK(P0,P1,tt,MW) do{ amask(P0,P1,MW); if(NEARF(tt)) abias(P0,P1,btl,qpos,(tt)*KVBLK,hi); }while(0)
  bool resc=false;
  #define NEARF(tt) (NT<=6)
  #define START(P0,P1) do{ float rm=rowmax(P0,P1); rm=max2f(rm,-1000.f); resc=false; mhat=rm; \
    _Pragma("unroll") for(int r=0;r<16;++r)P0[r]=__builtin_amdgcn_exp2f(P0[r]-mhat); }while(0)
  #define RESC() do{ if(resc){ asm volatile("s_waitcnt lgkmcnt(0)":::"memory"); \
      _Pragma("unroll") for(int d_=0;d_<2;++d_) _Pragma("unroll") for(int r=0;r<16;++r)o[d_][r]*=wsf[crow(r,hi)]; } }while(0)
  f32x16 pA0,pA1,pB0,pB1;
  int sl_prev=0,sl_cur=0,sl_next=SLOTB;
  #define ROT() do{sl_prev=sl_cur;sl_cur=sl_next;sl_next=(sl_next==(NSLOT-1)*SLOTB)?0:sl_next+SLOTB;}while(0)
  DMA_K(2,2*SLOTB);
  WAIT_BAR(3);
  qkt(pA0,pA1,Kbase,qr,r32,hi);asm volatile("s_nop 15\n\ts_nop 7":"+v"(pA0),"+v"(pA1));AMASK(pA0,pA1,0,mw); mw=mrowv[32];
  START(pA0,pA1);
  _Pragma("unroll") for(int r=0;r<16;++r)pA1[r]=__builtin_amdgcn_exp2f(pA1[r]-mhat);
  WAIT_BAR(0);
  DMA_K(3,0);DMA_V(1,SLOTB);
  ROT();
  kload8(kf,kp0+sl_cur);
  WAIT_BAR(2);
  s16x4 vlo[8],vhi[8]; u32x4 pw0,pw1,pw2,pw3;
  #define PKW(P,B) cvtpk_s(P[B],P[B+1])
  #define PAF(k) __builtin_bit_cast(h16x8,pw##k)
  #define VFR(i) vfr(vlo[i],vhi[i])
  #define PIN(x) asm volatile("":"+v"(x))
  #define MX3(a,b,c) __builtin_fmaxf(__builtin_fmaxf((a),(b)),(c))
  #define GAPA(MF,A0,A1,A2,A3,W0,W1,PW) do{ MF; sacc+=A0; sacc+=A1; sacc+=A2; sacc+=A3; PIN(sacc); W0; W1; PIN(PW); SBAR(); }while(0)
  #define EX(v) __builtin_amdgcn_exp2f(v)
  #define GAPB(MF,X,B) do{ MF; X[B]=EX(X[B]-mhat); X[B+1]=EX(X[B+1]-mhat); X[B+2]=EX(X[B+2]-mhat); X[B+3]=EX(X[B+3]-mhat); PIN(X); SBAR(); }while(0)
  #define VRD(i) do{ vlo[i]=vtr(vp_+(((i)>>2)*4096+((i)&3)*1024)); vhi[i]=vtr(vp_+(((i)>>2)*4096+((i)&3)*1024+512)); }while(0)
  #define KRD(G,j) do{ if(G){ kload2(kf,kp0+sl_next,j); SBAR(); } }while(0)
  #define STEP(C0,C1,P0,P1,t,GK,GV,GL) do{ SBAR(); \
    const lds_cptr vp_=vp0+sl_prev; \
    VRD(0); SBAR(); float sacc=(P0[0]+P0[1]); \
    GAPA(C0=MFMA16(kf[0],qr[0],(f32x16{})), P0[2],P0[3],P0[4],P0[5],     pw0[0]=PKW(P0,0), pw0[1]=PKW(P0,2), pw0); \
    VRD(4); SBAR(); GAPA(C1=MFMA16(kf[1],qr[0],(f32x16{})), P0[6],P0[7],P0[8],P0[9],     pw0[2]=PKW(P0,4), pw0[3]=PKW(P0,6), pw0); \
    VRD(1); SBAR(); GAPA(C0=MFMA16(kf[2],qr[1],C0),   P0[10],P0[11],P0[12],P0[13], pw1[0]=PKW(P0,8), pw1[1]=PKW(P0,10), pw1); \
    VRD(5); SBAR(); GAPA(C1=MFMA16(kf[3],qr[1],C1),   P0[14],P0[15],P1[0],P1[1],   pw1[2]=PKW(P0,12),pw1[3]=PKW(P0,14), pw1); \
    VRD(2); SBAR(); GAPA(C0=MFMA16(kf[4],qr[2],C0),   P1[2],P1[3],P1[4],P1[5],     pw2[0]=PKW(P1,0), pw2[1]=PKW(P1,2), pw2); \
    VRD(6); SBAR(); GAPA(C1=MFMA16(kf[5],qr[2],C1),   P1[6],P1[7],P1[8],P1[9],     pw2[2]=PKW(P1,4), pw2[3]=PKW(P1,6), pw2); \
    VRD(3); SBAR(); GAPA(C0=MFMA16(kf[6],qr[3],C0),   P1[10],P1[11],P1[12],P1[13], pw3[0]=PKW(P1,8), pw3[1]=PKW(P1,10), pw3); \
    VRD(7); SBAR(); GAPA(C1=MFMA16(kf[7],qr[3],C1),   P1[14],P1[15],0.f,0.f,       pw3[2]=PKW(P1,12),pw3[3]=PKW(P1,14), pw3); \
    l_reg+=sacc; \
    AMASK(C0,C1,t,mw); mw=mrowv[(size_t)(((t)+1<NT)?(t)+1:(t))*32]; \
    if(GK){DMA_K((t)+3,sl_cur);} if(GV){DMA_V((t)+1,sl_next);} \
    { float a=MX3(C0[0],C0[1],C1[0]),b=MX3(C0[2],C0[3],C1[1]); a=MX3(a,C1[2],C1[3]); \
      _Pragma("unroll") for(int r=4;r<16;r+=4){a=MX3(a,C0[r],C0[r+1]);b=MX3(b,C0[r+2],C0[r+3]);a=MX3(a,C1[r],C1[r+1]);b=MX3(b,C1[r+2],C1[r+3]);} \
      float rm=__builtin_fmaxf(a,b); { auto rr=__builtin_amdgcn_permlane32_swap(__float_as_uint(rm),__float_as_uint(rm),false,false); rm=__builtin_fmaxf(__uint_as_float(rr[0]),__uint_as_float(rr[1])); } \
      rm-=mhat; resc=false; \
      if(__builtin_expect(__any(rm>(float)THRL),0)){ const float dl=__builtin_fmaxf(rm,0.f); mhat+=dl; \
        const float f=__builtin_amdgcn_exp2f(-dl); l_reg*=f; if(hi==0)wsf[r32]=f; resc=true; } } \
    SBAR(); \
    GAPB(o[0]=MFMA16(PAF(0),VFR(0),o[0]), C0,0); \
    GAPB(o[1]=MFMA16(PAF(0),VFR(4),o[1]), C0,4); \
    KRD(GL,0); GAPB(o[0]=MFMA16(PAF(1),VFR(1),o[0]), C0,8); \
    KRD(GL,1); GAPB(o[1]=MFMA16(PAF(1),VFR(5),o[1]), C0,12); \
    KRD(GL,2); GAPB(o[0]=MFMA16(PAF(2),VFR(2),o[0]), C1,0); \
    KRD(GL,3); GAPB(o[1]=MFMA16(PAF(2),VFR(6),o[1]), C1,4); \
    GAPB(o[0]=MFMA16(PAF(3),VFR(3),o[0]), C1,8); \
    GAPB(o[1]=MFMA16(PAF(3),VFR(7),o[1]), C1,12); \
    }while(0)
  int t=1;
  #undef NEARF
  #define NEARF(tt) false
  #define ENDW(tt) do{ if((tt)+3<NT){WAIT_BAR(2);} else if((tt)+2<NT){WAIT_BAR(1);} else {WAIT_BAR(0);} }while(0)
  for(;t+7<NT;t+=2){
    STEP(pB0,pB1,pA0,pA1,t,true,true,true);     WAIT_BAR(2); RESC(); ROT();
    STEP(pA0,pA1,pB0,pB1,t+1,true,true,true);   WAIT_BAR(2); RESC(); ROT();
  }
  #undef NEARF
  #define NEARF(tt) ((tt)>=NT-6)
  for(;t+1<NT;t+=2){
    STEP(pB0,pB1,pA0,pA1,t,(t+3<NT),(t+1<NT),(t+1<NT));       ENDW(t);   RESC(); ROT();
    STEP(pA0,pA1,pB0,pB1,t+1,(t+4<NT),(t+2<NT),(t+2<NT));     ENDW(t+1); RESC(); ROT();
  }
  STEP(pB0,pB1,pA0,pA1,NT-1,false,false,false); RESC();
  #undef NEARF
  { float sacc=pB0[0]+pB0[1]; _Pragma("unroll") for(int r=2;r<16;++r)sacc+=pB0[r]; _Pragma("unroll") for(int r=0;r<16;++r)sacc+=pB1[r]; l_reg+=sacc;
    pw0=(u32x4){PKW(pB0,0),PKW(pB0,2),PKW(pB0,4),PKW(pB0,6)};pw1=(u32x4){PKW(pB0,8),PKW(pB0,10),PKW(pB0,12),PKW(pB0,14)};pw2=(u32x4){PKW(pB1,0),PKW(pB1,2),PKW(pB1,4),PKW(pB1,6)};pw3=(u32x4){PKW(pB1,8),PKW(pB1,10),PKW(pB1,12),PKW(pB1,14)};
    SBAR(); pv(o,vb0+sl_cur,PAF(0),PAF(1),PAF(2),PAF(3)); }
  #undef PKW
  #undef PAF
  #undef VFR
  #undef PIN
  #undef MX3
  #undef GAPA
  #undef GAPB
  #undef EX
  #undef VRD
  #undef KRD
  #undef STEP
  #undef ENDW
  {auto rr=__builtin_amdgcn_permlane32_swap(__float_as_uint(l_reg),__float_as_uint(l_reg),false,false);l_reg=__uint_as_float(rr[0])+__uint_as_float(rr[1]);}
  if(hi==0)wsf[32+r32]=l_reg;asm volatile("s_waitcnt lgkmcnt(0)":::"memory");
  float rli[16];
  #pragma unroll
  for(int r=0;r<16;++r)rli[r]=__builtin_amdgcn_rcpf(wsf[32+crow(r,hi)]);
  { h16*stg=(h16*)(shm+LDS_OST)+wid*2048;
    #pragma unroll
    for(int r=0;r<16;++r){const int orow=crow(r,hi);
      #pragma unroll
      for(int d0=0;d0<2;++d0)stg[orow*64+d0*32+r32]=(h16)(o[d0][r]*rli[r]);}
    asm volatile("s_waitcnt lgkmcnt(0)":::"memory");
    #pragma unroll
    for(int i=0;i<4;++i){const int row=i*8+(lane>>3),ch=lane&7; const h16x8 v=*(const h16x8*)(stg+row*64+ch*8);
      const long grow=rowbase+q0+wid*QBLK+row; const h16x8 z=*(const h16x8*)(AZ+grow*APITCH+h*D+ch*8);
      *(h16x8*)(MIXO+grow*DMIX+1024+h*D+ch*8)=v*z;} }
  asm volatile("s_waitcnt lgkmcnt(0)\n\ts_barrier":::"memory");
  #undef DMA_K
  #undef DMA_V
  #undef AMASK
  #undef START
  #undef RESC
  #undef ROT
}
constexpr int ATTN_LDS_BYTES=LDS_BYTES;
template<int THRL=8> __device__ __forceinline__ void attn_phase(char*lds,const Args&a){
  const int G=gridDim.x, bx=blockIdx.x; const int vcu=(G%8==0)?(bx%8)*(G/8)+bx/8:bx;
  const h16*Q=(const h16*)(a.ws+WS_AQ),*K=(const h16*)(a.ws+WS_AK),*V=(const h16*)(a.ws+WS_AV),*AZ=(const h16*)(a.ws+WS_AZ); h16*MIXO=(h16*)((unsigned char*)a.out+DO_MIX);
  const unsigned long long*MB=(const unsigned long long*)(a.ws+WS_MASKB); const float*BT=(const float*)(a.ws+WS_BT);
  for(int v=vcu;v<256;v+=G){ const int bh=v>>4,s=v&15;
    attn_unit<THRL>(bh>>3,bh&7,s,Q,K,V,AZ,MIXO,MB,BT,lds);
    attn_unit<THRL>(bh>>3,bh&7,31-s,Q,K,V,AZ,MIXO,MB,BT,lds); }
}
#undef SBAR
#undef WAIT_BAR
#undef MFMA16
}

__device__ __forceinline__ void phase_mask_convert(const Args& a) {
    const int lane = threadIdx.x & 63, gw = blockIdx.x * 8 + (threadIdx.x >> 6), NGW = gridDim.x * 8;
    const unsigned* MASK = (const unsigned*)(a.ws + WS_MASK); unsigned long long* MB = (unsigned long long*)(a.ws + WS_MASKB);
    for (int it = gw; it < 2 * 256 * 256; it += NGW) { const int kb = it & 255, qblk = (it >> 8) & 255, b = it >> 16;
        const unsigned w = MASK[(size_t)(b * SEQ + qblk * 32 + (lane & 31)) * 256 + kb];
        unsigned long long mine = 0ull;
#pragma unroll
        for (int r = 0; r < 16; ++r) { const int pos = (r & 3) + 8 * (r >> 2) + 4 * (lane >> 5); const unsigned long long bal = __ballot((w >> pos) & 1u); if (lane == r) mine = bal; }
        if (lane < 16) MB[(size_t)it * 16 + lane] = mine; }
}

constexpr int NPH = 8;
__global__ void __launch_bounds__(512, 2) fwd(Args a) {
    extern __shared__ __attribute__((aligned(16))) unsigned char lds_[];
    LAS unsigned char* lds = (LAS unsigned char*)lds_;
    volatile LAS unsigned* ctlw = (volatile LAS unsigned*)(lds + LDSCTL_OFF);
    const int tid = threadIdx.x;
    if (tid < 64) ctlw[tid] = 0u;
    __syncthreads();
    const int lo = a.ph_lo, hi = a.ph_hi;
    XcdBarrier bar; bar.bar = (unsigned*)(a.ws + WS_CTL) + CW_BAR; bar.x = 0; bar.st = nullptr;
    if (hi - lo > 1) bar = xcd_barrier_post((unsigned*)(a.ws + WS_CTL) + CW_BAR, ctlw + 8);
#define IN(k) (lo <= (k) && (k) < hi)
#define SEAM(k) do { if (IN(k) && IN((k) + 1)) xcd_barrier(bar); } while (0)
    if (IN(0)) phase_prologue(a, lds);
    SEAM(0);
    if (IN(1)) { pg8::Gemm g{(const h16*)(a.ws + WS_XN), (const h16*)(a.ws + WS_WIN), M, NPAD, DM}; pg8::StaticOrder S; S.init(M, NPAD, gridDim.x, blockIdx.x);
        pg8::EpiProj E{a.ws, (unsigned char*)a.out, a.in[3]};
        pg8::gemm_phase<pg8::EpiProj, pg8::StaticOrder, true, true>(lds, g, S, E); }
    SEAM(1);
    if (IN(2)) phase_conv(a);
    SEAM(2);
    if (IN(3)) { if (blockIdx.x < 64 && !(a.skip & 1)) mls::phase_mlstm(a, lds, blockIdx.x);
        if (!(a.skip & 2)) idx::phase_index(a, lds); }
    SEAM(3);
    if (IN(4)) { attn_body::attn_phase<8>((char*)lds_, a); phase_headnorm2(a); }
    SEAM(4);
    if (IN(5)) {
        { pg8::Gemm g{(const h16*)((unsigned char*)a.out + DO_MIX), (const h16*)(a.ws + WS_WOUT), M, DM, DMIX}; pg8::StaticOrder S; S.init(M, DM, gridDim.x, blockIdx.x);
          pg8::EpiOut E{a.in[0], (float*)(a.ws + WS_H1), (h16*)(a.ws + WS_H1H)};
          pg8::gemm_phase<pg8::EpiOut, pg8::StaticOrder, false, true>(lds, g, S, E); }
        { pg8::Gemm g{(const h16*)(a.ws + WS_P16), (const h16*)(a.ws + WS_WPLE), M, DM, DPLE}; pg8::StaticOrder S; S.init(M, DM, gridDim.x, blockIdx.x);
          pg8::EpiF16 E{(h16*)(a.ws + WS_PB), DM};
          pg8::gemm_phase<pg8::EpiF16, pg8::StaticOrder, false, true>(lds, g, S, E); } }
    SEAM(5);
    if (IN(6)) { pg8::Gemm g{(const h16*)(a.ws + WS_H1H), (const h16*)(a.ws + WS_WGATE), M, DM, DM}; pg8::StaticOrder S; S.init(M, DM, gridDim.x, blockIdx.x);
        pg8::EpiF32 E{a.out, DM};
        pg8::gemm_phase<pg8::EpiF32, pg8::StaticOrder, false, true>(lds, g, S, E); }
    SEAM(6);
    if (IN(7)) phase_tail(a);
#undef IN
#undef SEAM
}
#if DEBUG_CHECKS
__device__ __forceinline__ void flag_err(unsigned* flags, int idx, float ref, float got) {
    const float e = fabsf(ref - got) / (0.03f + 0.02f * fabsf(ref));
    atomicMax(&flags[idx], __float_as_uint(e == e ? e : 1e30f));
}
__global__ void __launch_bounds__(512) k_check_proj(Args a) {
    __shared__ float u[1024]; __shared__ float red[8];
    const int tid = threadIdx.x, lane = tid & 63, wave = tid >> 6; const int r = blockIdx.x;
    unsigned* flags = (unsigned*)(a.ws + WS_FLAGS);
    const float* x = a.in[0] + (size_t)r * DM; const float* g = a.in[6]; const float* W = a.in[2]; const float* bg = a.in[3];
    float s = 0.f; for (int k = tid; k < DM; k += 512) s += x[k] * x[k];
    s = wave_sum(s); if (lane == 0) red[wave] = s; __syncthreads();
    float tot = 0.f; for (int w = 0; w < 8; ++w) tot += red[w];
    const float rstd = 1.0f / sqrtf(tot / DM + EPS);
    for (int k = tid; k < DM; k += 512) u[k] = x[k] * rstd * g[k];
    __syncthreads();
    const h16* MQ = (const h16*)((unsigned char*)a.out + DO_MQ); const h16* MK = (const h16*)((unsigned char*)a.out + DO_MK); const h16* MV = (const h16*)((unsigned char*)a.out + DO_MV);
    const h16* MG = (const h16*)(a.ws + WS_MG); const h16* AQ = (const h16*)(a.ws + WS_AQ); const h16* AK = (const h16*)(a.ws + WS_AK); const h16* AV = (const h16*)(a.ws + WS_AV); const h16* AZ = (const h16*)(a.ws + WS_AZ);
    const h16* IQ = (const h16*)(a.ws + WS_IQ); const h16* IK = (const h16*)(a.ws + WS_IK); const float* IW = (const float*)(a.ws + WS_IW); const float* GT = (const float*)(a.ws + WS_GATES);
    for (int c = tid; c < NPROJ; c += 512) {
        float d = 0.f; for (int k = 0; k < DM; ++k) d += u[k] * W[(size_t)k * NPROJ + c];
        if (c < 512) flag_err(flags, 0, d, (float)MQ[(size_t)r * 512 + c]);
        else if (c < 1024) flag_err(flags, 0, d, (float)MK[(size_t)r * 512 + c - 512]);
        else if (c < 2048) flag_err(flags, 0, d, (float)MV[(size_t)r * 1024 + c - 1024]);
        else if (c < 3072) { float z = 0.f; for (int k = 0; k < DM; ++k) z += u[k] * W[(size_t)k * NPROJ + c + 1024];
            flag_err(flags, 1, sigmoidf_(d) * siluf_(z), (float)MG[(size_t)r * 1024 + c - 2048]); }
        else if (c < 4096) {}
        else if (c < 4100) flag_err(flags, 3, d + bg[c - 4096], GT[(size_t)r * 8 + c - 4096]);
        else if (c < 4104) { const float gg = d + bg[c - 4096]; flag_err(flags, 3, fminf(gg, 0.f) - log1pf(expf(-fabsf(gg))), GT[(size_t)r * 8 + c - 4096]); }
        else if (c < 4616) flag_err(flags, 2, d * C2, (float)AQ[(size_t)r * 512 + c - 4104]);
        else if (c < 5128) flag_err(flags, 2, d, (float)AK[(size_t)r * 512 + c - 4616]);
        else if (c < 5640) flag_err(flags, 2, d, (float)AV[(size_t)r * 512 + c - 5128]);
        else if (c < 6152) flag_err(flags, 2, siluf_(d), (float)AZ[(size_t)r * 512 + c - 5640]);
        else if (c < 6664) flag_err(flags, 3, d * 0.125f, (float)IQ[(size_t)r * 512 + c - 6152]);
        else if (c < 6728) flag_err(flags, 3, d, (float)IK[(size_t)r * 64 + c - 6664]);
        else flag_err(flags, 3, d * 0.35355339059327373f, IW[(size_t)r * 8 + c - 6728]);
    }
}
__global__ void __launch_bounds__(512) k_check_out(Args a) {
    __shared__ float mx[1536]; __shared__ float pr[256]; __shared__ float h1row[1024]; __shared__ float erow[1024];
    const int tid = threadIdx.x; const int i = blockIdx.x; const int r = i * 128 + ((i * 37) & 127);
    unsigned* flags = (unsigned*)(a.ws + WS_FLAGS);
    const h16* MIX = (const h16*)((unsigned char*)a.out) + (size_t)r * DMIX; const float* p = a.in[1] + (size_t)r * DPLE;
    for (int k = tid; k < DMIX; k += 512) mx[k] = (float)MIX[k];
    if (tid < 256) pr[tid] = p[tid];
    __syncthreads();
    const float* Wo = a.in[5]; const float* Wp = a.in[9]; const float* x = a.in[0] + (size_t)r * DM;
    const float* H1 = (const float*)(a.ws + WS_H1) + (size_t)r * DM; const h16* H1H = (const h16*)(a.ws + WS_H1H) + (size_t)r * DM; const h16* PB = (const h16*)(a.ws + WS_PB) + (size_t)r * DM;
    for (int c = tid; c < DM; c += 512) {
        float d = x[c]; for (int k = 0; k < DMIX; ++k) d += mx[k] * Wo[(size_t)k * DM + c];
        flag_err(flags, 4, d, H1[c]); flag_err(flags, 4, d, (float)H1H[c]);
        float e = 0.f; for (int k = 0; k < DPLE; ++k) e += pr[k] * Wp[(size_t)k * DM + c];
        flag_err(flags, 5, e, (float)PB[c]);
        h1row[c] = d; erow[c] = e;
    }
    __syncthreads();
    const float* Wg = a.in[10]; float* DBG = (float*)(a.ws + WS_DBG) + (size_t)i * DM;
    for (int c = tid; c < DM; c += 512) { float gsum = 0.f; for (int k = 0; k < DM; ++k) gsum += h1row[k] * Wg[(size_t)k * DM + c];
        DBG[c] = h1row[c] + erow[c] * sigmoidf_(gsum); }
    if (tid < 64) { float s1 = 0.f, s2 = 0.f; for (int k = tid; k < 1024; k += 64) s1 += mx[k] * mx[k]; for (int k = 1024 + tid; k < 1536; k += 64) s2 += mx[k] * mx[k];
        s1 = wave_sum(s1) / 1024.f; s2 = wave_sum(s2) / 512.f;
        if (tid == 0) { if (!(s1 > 0.02f && s1 < 0.4f)) atomicMax(&flags[7], __float_as_uint(2.0f)); if (!(s2 > 0.0003f && s2 < 0.05f)) atomicMax(&flags[8], __float_as_uint(2.0f)); } }
}
__global__ void __launch_bounds__(512) k_check_h2(Args a) {
    const int tid = threadIdx.x; const int i = blockIdx.x; const int r = i * 128 + ((i * 37) & 127);
    unsigned* flags = (unsigned*)(a.ws + WS_FLAGS);
    const float* H2 = (const float*)(a.ws + WS_H1) + (size_t)r * DM; const float* DBG = (const float*)(a.ws + WS_DBG) + (size_t)i * DM;
    for (int c = tid; c < DM; c += 512) flag_err(flags, 6, DBG[c], H2[c]);
}

__global__ void __launch_bounds__(512) k_check_mlstm(Args a) {
    __shared__ float qt[128]; __shared__ float wgt[SEQ]; __shared__ float red[16]; __shared__ float F[SEQ];
    const int tid = threadIdx.x, lane = tid & 63, wave = tid >> 6;
    const int ti = blockIdx.x & 7;
    const int t = ti == 0 ? 65 : ti == 1 ? 500 : ti == 2 ? 1000 : ti == 3 ? 2047 : ti == 4 ? 2048 : ti == 5 ? 4100 : ti == 6 ? 6000 : 8191, b = (blockIdx.x >> 3) & 1, h = (blockIdx.x >> 3) ? 3 : 0;
    unsigned* flags = (unsigned*)(a.ws + WS_FLAGS);
    const h16* MQ = (const h16*)((unsigned char*)a.out + DO_MQ); const h16* MK = (const h16*)((unsigned char*)a.out + DO_MK); const h16* MV = (const h16*)((unsigned char*)a.out + DO_MV);
    const float* GT = (const float*)(a.ws + WS_GATES); const float* cw = a.in[4]; const float* HR = (const float*)(a.ws + WS_H1);
    if (tid < 128) { float y = 0.f; for (int j = 0; j < 4; ++j) { const int tt = t - 3 + j; if (tt >= 0) y += cw[j * 1024 + h * 128 + tid] * (float)MQ[(size_t)(b * SEQ + tt) * 512 + h * 128 + tid]; } qt[tid] = siluf_(y); }
    if (tid == 0) { float acc = 0.f; for (int s = 0; s <= t; ++s) { acc += GT[(size_t)(b * SEQ + s) * 8 + 4 + h]; F[s] = acc; } }
    __syncthreads();
    const float Ft = F[t];
    __syncthreads();
    float mx = -1e30f;
    for (int s = tid; s <= t; s += 512) { float qk = 0.f;
#pragma unroll 1
        for (int d = 0; d < 128; ++d) { float y = 0.f;
#pragma unroll
            for (int j = 0; j < 4; ++j) { const int tt = s - 3 + j; if (tt >= 0) y += cw[j * 1024 + 512 + h * 128 + d] * (float)MK[(size_t)(b * SEQ + tt) * 512 + h * 128 + d]; }
            qk += qt[d] * siluf_(y) * 0.08838834764831845f; }
        const float Dts = Ft - F[s] + GT[(size_t)(b * SEQ + s) * 8 + h]; mx = fmaxf(mx, Dts); wgt[s] = qk; F[s] = Dts; }
    __syncthreads();
#pragma unroll
    for (int o = 1; o < 64; o <<= 1) mx = fmaxf(mx, __shfl_xor(mx, o));
    if (lane == 0) red[wave] = mx; __syncthreads();
    float mt = Ft; for (int w = 0; w < 8; ++w) mt = fmaxf(mt, red[w]);
    float ds = 0.f;
    for (int s = tid; s <= t; s += 512) { const float wv = wgt[s] * expf(F[s] - mt); wgt[s] = wv; ds += wv; }
    ds = wave_sum(ds); if (lane == 0) red[8 + wave] = ds; __syncthreads();
    float den = 0.f; for (int w = 0; w < 8; ++w) den += red[8 + w];
    den = fmaxf(fabsf(den), expf(-mt));
    if (tid < 256) { float num = 0.f; for (int s = 0; s <= t; ++s) num += wgt[s] * (float)MV[(size_t)(b * SEQ + s) * 1024 + h * 256 + tid];
        flag_err(flags, 9, num / den, HR[(size_t)(b * SEQ + t) * 1024 + h * 256 + tid]); }
}
__global__ void __launch_bounds__(512) k_check_dsa(Args a) {
    __shared__ float sc[SEQ]; __shared__ float qf[512]; __shared__ int sel[256]; __shared__ int nsel; __shared__ float lg[8][256]; __shared__ float hm[8], hs[8];
    const int tid = threadIdx.x; const int ti = blockIdx.x & 7;
    const int t = ti == 0 ? 0 : ti == 1 ? 100 : ti == 2 ? 255 : ti == 3 ? 256 : ti == 4 ? 300 : ti == 5 ? 1000 : ti == 6 ? 5000 : 8191, b = blockIdx.x >> 3, row = b * SEQ + t;
    unsigned* flags = (unsigned*)(a.ws + WS_FLAGS);
    const h16* IQ = (const h16*)(a.ws + WS_IQ); const h16* IK = (const h16*)(a.ws + WS_IK); const float* IW = (const float*)(a.ws + WS_IW);
    const h16* AQ = (const h16*)(a.ws + WS_AQ); const h16* AK = (const h16*)(a.ws + WS_AK); const h16* AV = (const h16*)(a.ws + WS_AV); const h16* AZ = (const h16*)(a.ws + WS_AZ);
    const h16* MIX = (const h16*)((unsigned char*)a.out); const float* rb = a.in[8];
    qf[tid] = (float)IQ[(size_t)row * 512 + tid]; if (tid == 0) nsel = 0;
    __syncthreads();
    for (int s = tid; s <= t; s += 512) { float tot = 0.f;
#pragma unroll 1
        for (int hh = 0; hh < 8; ++hh) { float d = 0.f;
#pragma unroll 4
            for (int j = 0; j < 64; ++j) d += qf[hh * 64 + j] * (float)IK[(size_t)(b * SEQ + s) * 64 + j]; tot += IW[(size_t)row * 8 + hh] * fmaxf(d, 0.f); }
        sc[s] = tot; }
    __syncthreads();
    for (int s = tid; s <= t; s += 512) { const float v = sc[s]; int rank = 0; for (int s2 = 0; s2 <= t; ++s2) { const float v2 = sc[s2]; rank += (v2 > v || (v2 == v && s2 < s)) ? 1 : 0; }
        if (rank < 256) { const int p = atomicAdd(&nsel, 1); sel[p] = s; } }
    __syncthreads();
    const int ns = nsel;
    qf[tid] = (float)AQ[(size_t)row * 512 + tid];
    __syncthreads();
    for (int i = tid; i < 8 * ns; i += 512) { const int hh = i / ns, j = i % ns, s = sel[j]; float d = 0.f;
        for (int k = 0; k < 64; ++k) d += qf[hh * 64 + k] * (float)AK[(size_t)(b * SEQ + s) * 512 + hh * 64 + k];
        lg[hh][j] = d + rb[t5_bucket(t - s) * 8 + hh] * LOG2E; }
    __syncthreads();
    if (tid < 8) { float m = -1e30f; for (int j = 0; j < ns; ++j) m = fmaxf(m, lg[tid][j]); float ssum = 0.f; for (int j = 0; j < ns; ++j) ssum += exp2f(lg[tid][j] - m); hm[tid] = m; hs[tid] = ssum; }
    __syncthreads();
    { const int hh = tid >> 6, d = tid & 63; float o = 0.f; for (int j = 0; j < ns; ++j) o += exp2f(lg[hh][j] - hm[hh]) * (float)AV[(size_t)(b * SEQ + sel[j]) * 512 + hh * 64 + d];
      const float ref = o / hs[hh] * (float)AZ[(size_t)row * 512 + tid];
      const float got = (float)MIX[(size_t)row * DMIX + 1024 + tid];
      const float e = fabsf(ref - got) / (0.003f + 0.02f * fabsf(ref)); atomicMax(&flags[10], __float_as_uint(e == e ? e : 1e30f)); }
}

__global__ void __launch_bounds__(256) k_check_headnorm(Args a) {
    __shared__ float red[4];
    const int tid = threadIdx.x, lane = tid & 63, wave = tid >> 6, row = blockIdx.x >> 2, h = blockIdx.x & 3;
    unsigned* flags = (unsigned*)(a.ws + WS_FLAGS);
    const float* HR = (const float*)(a.ws + WS_H1) + (size_t)row * 1024 + h * 256; const h16* MG = (const h16*)(a.ws + WS_MG) + (size_t)row * 1024 + h * 256;
    const h16* MIX = (const h16*)((unsigned char*)a.out) + (size_t)row * DMIX + h * 256; const float* mn = a.in[7] + h * 256;
    const float v = HR[tid]; float s = wave_sum(v * v); if (lane == 0) red[wave] = s; __syncthreads();
    const float tot = red[0] + red[1] + red[2] + red[3];
    const float ref = v / sqrtf(tot / 256.f + EPS) * mn[tid] * (float)MG[tid];
    const float got = (float)MIX[tid]; const float e = fabsf(ref - got) / (0.003f + 0.01f * fabsf(ref)); atomicMax(&flags[11], __float_as_uint(e == e ? e : 1e30f));
    if (!(e <= 1.0f)) { atomicAdd(&flags[20], 1u); atomicMax(&flags[21], 65535u - (unsigned)blockIdx.x); atomicMax(&flags[22], (unsigned)blockIdx.x); }
}

#endif

extern "C" void kernel_launch(void* const* d_in, const int* in_sizes, int n_in, void* d_out, int out_size, void* d_ws, size_t ws_size, hipStream_t stream) {
    static int ok = 0;
    if (ok == 0) {
        if (n_in != 12 || in_sizes[0] != M * DM || out_size != M * DM || ws_size < WS_END) { fprintf(stderr, "kernel_launch: unexpected shapes (n_in %d, ws %zu)\n", n_in, ws_size); ok = -1; return; }
        if (hipFuncSetAttribute((const void*)fwd, hipFuncAttributeMaxDynamicSharedMemorySize, LDS_BYTES) != hipSuccess) { fprintf(stderr, "kernel_launch: hipFuncSetAttribute failed\n"); ok = -1; return; }
        ok = 1;
    }
    if (ok < 0) return;
    (void)hipMemsetAsync((char*)d_ws + WS_CTL, 0, CTL_ZERO_BYTES, stream);
    Args a{};
    for (int i = 0; i < 12; ++i) a.in[i] = (const float*)d_in[i];
    a.out = (float*)d_out; a.ws = (unsigned char*)d_ws;
#if DEBUG_CHECKS
    for (int ph = 0; ph < NPH; ++ph) { a.ph_lo = ph; a.ph_hi = ph + 1; hipLaunchKernelGGL(fwd, dim3(256), dim3(512), LDS_BYTES, stream, a);
        if (ph == 1) hipLaunchKernelGGL(k_check_proj, dim3(M), dim3(512), 0, stream, a);
        if (ph == 3) hipLaunchKernelGGL(k_check_mlstm, dim3(16), dim3(512), 0, stream, a);
        if (ph == 4) { hipLaunchKernelGGL(k_check_headnorm, dim3(M * 4), dim3(256), 0, stream, a); hipLaunchKernelGGL(k_check_dsa, dim3(16), dim3(512), 0, stream, a); }
        if (ph == 5) hipLaunchKernelGGL(k_check_out, dim3(128), dim3(512), 0, stream, a); }
#elif PROBE_PHASE >= 0
    a.ph_lo = 0; a.ph_hi = PROBE_PHASE + 1; hipLaunchKernelGGL(fwd, dim3(256), dim3(512), LDS_BYTES, stream, a);
    (void)hipMemsetAsync((char*)d_ws + WS_CTL, 0, 65536, stream);
    a.ph_lo = PROBE_PHASE; a.ph_hi = PROBE_PHASE + 1; a.skip = PROBE_SKIP; hipLaunchKernelGGL(fwd, dim3(256), dim3(512), LDS_BYTES, stream, a); a.skip = 0;
    (void)hipMemsetAsync((char*)d_ws + WS_CTL, 0, 65536, stream);
    a.ph_lo = PROBE_PHASE + 1; a.ph_hi = NPH; hipLaunchKernelGGL(fwd, dim3(256), dim3(512), LDS_BYTES, stream, a);
#else
    a.ph_lo = 0; a.ph_hi = NPH;
    hipLaunchKernelGGL(fwd, dim3(256), dim3(512), LDS_BYTES, stream, a);
#endif
}
```
